# Optimizing an MI355X kernel written in HIP

```python
import functools
import jax, jax.numpy as jnp
from jax import lax
import numpy as np

D_MODEL = 1024
BATCH = 2
SEQ = 8192
DEPTH = 1
DEC_BATCH = 128
DEC_SEQ = 1
PAST_LEN = 16384
PAGE_SIZE = 128

N_HEADS = 8
N_KV_HEADS = 2
HEAD_DIM = 64
GROUP = N_HEADS // N_KV_HEADS
WINDOW = 128
BLOCK = WINDOW
D_ATTN = N_HEADS * HEAD_DIM
D_KV = N_KV_HEADS * HEAD_DIM
D_CONV = D_MODEL // 2
CONV_W = 3
D_FF = 2816
FFN_CONV_W = 3
SPLITS = [D_ATTN, D_KV, D_KV, D_CONV, D_CONV, D_CONV, D_MODEL, D_MODEL]
N_PROJ = sum(SPLITS)
DN_ALPHA = (2 * DEPTH) ** 0.25
DN_BETA = (8 * DEPTH) ** -0.25
LN_EPS = 1e-5
NEG_INF = -1e30

kernel_name = "hybrid_swa_sink_alibi_shortconv_convffn_deepnorm_step"


def alibi_slopes():
    s = 2.0 ** (-8.0 * np.arange(1, N_HEADS + 1) / N_HEADS)
    return jnp.asarray(s, dtype=jnp.float32).reshape(N_KV_HEADS, GROUP)


def layer_norm(x, g, b):
    xf = x.astype(jnp.float32)
    mu = jnp.mean(xf, axis=-1, keepdims=True)
    var = jnp.mean(jnp.square(xf - mu), axis=-1, keepdims=True)
    y = (xf - mu) * lax.rsqrt(var + LN_EPS) * g.astype(jnp.float32) + b.astype(jnp.float32)
    return y.astype(x.dtype)


def causal_dwconv(hist, u, w):
    k_w = w.shape[0]
    full = jnp.concatenate([hist, u], axis=1)
    n_l = u.shape[1]
    y = sum(w[i] * full[:, i:i + n_l] for i in range(k_w))
    return y, full[:, -(k_w - 1):]


def band_softmax(q, k, v, dist, valid, sinks):
    scale = HEAD_DIM ** -0.5
    slopes = alibi_slopes()[:, :, None, None]
    s = jnp.einsum('...qkgd,...skd->...kgqs', q, k).astype(jnp.float32) * scale
    s = s - slopes * dist.astype(jnp.float32)
    s = jnp.where(valid, s, NEG_INF)
    sink = sinks.astype(jnp.float32).reshape(N_KV_HEADS, GROUP)[:, :, None, None]
    m = jnp.maximum(jnp.max(s, axis=-1, keepdims=True), sink)
    p = jnp.exp(s - m)
    denom = jnp.sum(p, axis=-1, keepdims=True) + jnp.exp(sink - m)
    probs = (p / denom).astype(v.dtype)
    return jnp.einsum('...kgqs,...skd->...qkgd', probs, v)


def attend_prompt(q, k, v, sinks):
    n_b, n_l = q.shape[0], q.shape[1]
    nb = n_l // BLOCK
    qb = q.reshape(n_b, nb, BLOCK, N_KV_HEADS, GROUP, HEAD_DIM)
    def band(t):
        tb = t.reshape(n_b, nb, BLOCK, N_KV_HEADS, HEAD_DIM)
        prev = jnp.concatenate([jnp.zeros_like(tb[:, :1]), tb[:, :-1]], axis=1)
        return jnp.concatenate([prev, tb], axis=2)
    kb, vb = band(k), band(v)
    a = jnp.arange(BLOCK)[:, None]
    j = jnp.arange(2 * BLOCK)[None, :]
    dist = a + BLOCK - j
    blk = jnp.arange(nb)[:, None, None]
    valid = (dist >= 0) & (dist <= WINDOW) & (blk * BLOCK - BLOCK + j >= 0)
    o = band_softmax(qb, kb, vb, dist, valid[:, None, None], sinks)
    return o.reshape(n_b, n_l, D_ATTN), k[:, -WINDOW:], v[:, -WINDOW:]


def attend_sample(q, k, v, sinks, cache_k, cache_v):
    w_c = cache_k.shape[1]
    keys = jnp.concatenate([cache_k, k], axis=1)
    vals = jnp.concatenate([cache_v, v], axis=1)
    n_t, n_s = q.shape[1], keys.shape[1]
    dist = jnp.arange(n_t)[:, None] + w_c - jnp.arange(n_s)[None, :]
    valid = (dist >= 0) & (dist <= WINDOW)
    o = band_softmax(q, keys, vals, dist, valid, sinks)
    return o.reshape(q.shape[0], n_t, D_ATTN), keys[:, -w_c:], vals[:, -w_c:]


def decoder_layer(x, attend, conv_hist, ffn_hist, w_in, conv_w, w_attn_out, w_conv_out,
                  w_mix_out, ln1_g, ln1_b, w_gate, w_up, ffn_conv_w, w_down, ln2_g, ln2_b):
    n, n_l = x.shape[0], x.shape[1]
    p = x @ w_in
    offs = list(np.cumsum(SPLITS)[:-1])
    q, k, v, cb, cc, ch, ga, gb = jnp.split(p, offs, axis=-1)
    q = q.reshape(n, n_l, N_KV_HEADS, GROUP, HEAD_DIM)
    k = k.reshape(n, n_l, N_KV_HEADS, HEAD_DIM)
    v = v.reshape(n, n_l, N_KV_HEADS, HEAD_DIM)
    o_att, new_k, new_v = attend(q, k, v)
    o_a = o_att @ w_attn_out
    u = cc * ch
    uc, new_conv = causal_dwconv(conv_hist, u, conv_w)
    o_c = (cb * uc) @ w_conv_out
    merged = jax.nn.sigmoid(ga) * o_a + jax.nn.sigmoid(gb) * o_c
    x1 = layer_norm(DN_ALPHA * x + merged @ w_mix_out, ln1_g, ln1_b)
    g_pre = x1 @ w_gate
    g_conv, new_ffn = causal_dwconv(ffn_hist, g_pre, ffn_conv_w)
    f = (jax.nn.gelu(g_conv, approximate=False) * (x1 @ w_up)) @ w_down
    x2 = layer_norm(DN_ALPHA * x1 + f, ln2_g, ln2_b)
    return x2, new_k, new_v, new_conv, new_ffn


def setup_inputs(seed: int = 0) -> dict:
    key = jax.random.key(seed)
    ks = jax.random.split(key, 20)
    f32 = jnp.float32
    nrm = lambda k, shape, s: jax.random.normal(k, shape, f32) * s
    col_scale = jnp.ones((N_PROJ,), f32).at[D_ATTN + D_KV:D_ATTN + 2 * D_KV].set(DN_BETA)
    return {
        "x_prompt": nrm(ks[0], (BATCH, SEQ, D_MODEL), 1.0),
        "x_sample": nrm(ks[1], (DEC_BATCH, DEC_SEQ, D_MODEL), 1.0),
        "cache_k": nrm(ks[2], (DEPTH, DEC_BATCH, WINDOW, N_KV_HEADS, HEAD_DIM), 1.0),
        "cache_v": nrm(ks[3], (DEPTH, DEC_BATCH, WINDOW, N_KV_HEADS, HEAD_DIM), 1.0),
        "state_conv": nrm(ks[4], (DEPTH, DEC_BATCH, CONV_W - 1, D_CONV), 1.0),
        "state_ffn_conv": nrm(ks[5], (DEPTH, DEC_BATCH, FFN_CONV_W - 1, D_FF), 1.0),
        "w_in": nrm(ks[6], (DEPTH, D_MODEL, N_PROJ), D_MODEL ** -0.5) * col_scale,
        "conv_w": nrm(ks[7], (DEPTH, CONV_W, D_CONV), CONV_W ** -0.5),
        "attn_sinks": nrm(ks[8], (DEPTH, N_HEADS), 0.5),
        "w_attn_out": nrm(ks[9], (DEPTH, D_ATTN, D_MODEL), D_ATTN ** -0.5 * DN_BETA),
        "w_conv_out": nrm(ks[10], (DEPTH, D_CONV, D_MODEL), D_CONV ** -0.5 * DN_BETA),
        "w_mix_out": nrm(ks[11], (DEPTH, D_MODEL, D_MODEL), D_MODEL ** -0.5 * DN_BETA),
        "ln1_g": 1.0 + nrm(ks[12], (DEPTH, D_MODEL), 0.02),
        "ln1_b": nrm(ks[13], (DEPTH, D_MODEL), 0.02),
        "w_gate": nrm(ks[14], (DEPTH, D_MODEL, D_FF), D_MODEL ** -0.5),
        "w_up": nrm(ks[15], (DEPTH, D_MODEL, D_FF), D_MODEL ** -0.5),
        "ffn_conv_w": nrm(ks[16], (DEPTH, FFN_CONV_W, D_FF), FFN_CONV_W ** -0.5),
        "w_down": nrm(ks[17], (DEPTH, D_FF, D_MODEL), D_FF ** -0.5 * DN_BETA),
        "ln2_g": 1.0 + nrm(ks[18], (DEPTH, D_MODEL), 0.02),
        "ln2_b": nrm(ks[19], (DEPTH, D_MODEL), 0.02),
    }


def reference(x_prompt, x_sample, cache_k, cache_v, state_conv, state_ffn_conv, w_in, conv_w,
              attn_sinks, w_attn_out, w_conv_out, w_mix_out, ln1_g, ln1_b, w_gate, w_up,
              ffn_conv_w, w_down, ln2_g, ln2_b):
    yp, ys = x_prompt, x_sample
    kp_l, vp_l, cp_l, fp_l, ks_l, vs_l, cs_l, fs_l = [], [], [], [], [], [], [], []
    for l in range(DEPTH):
        params = (w_in[l], conv_w[l], w_attn_out[l], w_conv_out[l], w_mix_out[l], ln1_g[l], ln1_b[l],
                  w_gate[l], w_up[l], ffn_conv_w[l], w_down[l], ln2_g[l], ln2_b[l])
        zc = jnp.zeros((yp.shape[0], CONV_W - 1, D_CONV), yp.dtype)
        zf = jnp.zeros((yp.shape[0], FFN_CONV_W - 1, D_FF), yp.dtype)
        yp, kp, vp, cp, fp = decoder_layer(
            yp, functools.partial(attend_prompt, sinks=attn_sinks[l]), zc, zf, *params)
        ys, k_s, v_s, c_s, f_s = decoder_layer(
            ys, functools.partial(attend_sample, sinks=attn_sinks[l], cache_k=cache_k[l], cache_v=cache_v[l]),
            state_conv[l], state_ffn_conv[l], *params)
        kp_l.append(kp); vp_l.append(vp); cp_l.append(cp); fp_l.append(fp)
        ks_l.append(k_s); vs_l.append(v_s); cs_l.append(c_s); fs_l.append(f_s)
    return (yp, ys, jnp.stack(kp_l), jnp.stack(vp_l), jnp.stack(cp_l), jnp.stack(fp_l),
            jnp.stack(ks_l), jnp.stack(vs_l), jnp.stack(cs_l), jnp.stack(fs_l))
```

```cpp
#include <hip/hip_runtime.h>
#include <hip/hip_cooperative_groups.h>
#include <cstdio>
#include <cstdint>
namespace cg = cooperative_groups;
#define MK_N_LAUNCHES 10
namespace pg8 {
#define PG8_LAS __attribute__((address_space(3)))
typedef unsigned short bf16_t;
typedef short bf16x8 __attribute__((ext_vector_type(8)));
typedef float f32x4 __attribute__((ext_vector_type(4)));
typedef unsigned u32x4 __attribute__((ext_vector_type(4)));
constexpr int BM = 256, BK = 64, HALF = 128, HTB = HALF * BK * 2  , STAGE_BYTES = 8 * HTB, NXCD = 8, WGM = 8;

__host__ __device__ __forceinline__ int lds_byte(int r, int c) { const int st = (r >> 4) * 2 + (c >> 5), rr = r & 15, cc = c & 31, ob = rr * 64 + cc * 2; return st * 1024 + (ob ^ (((ob >> 9) & 1) << 5)); }
__host__ __device__ __forceinline__ void stage_rc(int b, int& R, int& C) { const int st = b / 1024, sb = b % 1024, swz = sb ^ (((sb >> 9) & 1) << 5); R = (st >> 1) * 16 + swz / 64; C = (st & 1) * 32 + (swz % 64) / 2; }
__host__ __device__ __forceinline__ int perm32(int rho) { const int n = rho >> 4, i = rho & 15; return 8 * (i >> 2) + 4 * n + (i & 3); }

struct Unit { int pm, pn; };
struct Gemm { const bf16_t* A; const bf16_t* Bt; int M, N, K; };

struct StaticOrder {
    int nM, nN, nwg, G, c;
    __host__ __device__ void init(int M, int N, int G_, int c_) { nM = M / BM; nN = N / BM; nwg = nM * nN; G = G_; c = c_; }
    __host__ __device__ bool next(int i, Unit& u) const {
        const long L = (long)i * G + c; if (L >= nwg) return false;
        int wgid = (int)L; { const int q = nwg / NXCD, r = nwg % NXCD, xcd = wgid % NXCD, off = wgid / NXCD; wgid = (xcd < r ? xcd * (q + 1) : r * (q + 1) + (xcd - r) * q) + off; }
        const int nig = WGM * nN, gid = wgid / nig, fm = gid * WGM, gsz = (nM - fm) < WGM ? (nM - fm) : WGM;
        u.pm = fm + ((wgid % nig) % gsz); u.pn = (wgid % nig) / gsz; return true;
    }
    __device__ __forceinline__ void a_ready(const Unit&) const {}
    __device__ __forceinline__ void done(const Unit&) const {}
};

__device__ __forceinline__ unsigned cvt_pk_bf16(float lo, float hi) { unsigned r; asm volatile("v_cvt_pk_bf16_f32 %0, %1, %2" : "=v"(r) : "v"(lo), "v"(hi)); return r; }
typedef float f32x2 __attribute__((ext_vector_type(2)));
__device__ __forceinline__ f32x2 gelu_pk(f32x2 v) {
    const f32x2 av = __builtin_elementwise_abs(v), d = av * 0.2316418882f + 1.0f;
    f32x2 t; t.x = __builtin_amdgcn_rcpf(d.x); t.y = __builtin_amdgcn_rcpf(d.y);
    f32x2 q = t * 0.5307027145f + (-0.7265760135f); q = q * t + 0.7107068705f; q = q * t + (-0.142248368f); q = q * t + 0.127414796f; q = q * t;
    const f32x2 s = (v * v) * (-0.72134752044f);
    f32x2 e; e.x = __builtin_amdgcn_exp2f(s.x); e.y = __builtin_amdgcn_exp2f(s.y);
    const f32x2 m = v * (q * e), r = v - m;
    f32x2 o; o.x = v.x < 0.f ? m.x : r.x; o.y = v.y < 0.f ? m.y : r.y; return o;
}

template <int ACT  > struct EpiBf16 {
    static constexpr bool PERM = true, AFTER_DRAIN = false; static_assert(ACT == 0 || ACT == 1, "EpiBf16: ACT is 0 (none) or 1 (gelu_pk)");
    bf16_t* O; int ldc; const float* bias; int split_cols; size_t split_stride; float scale0;
    __device__ __forceinline__ void operator()(const f32x4 (&acc)[2][2][4][2], const Unit& u, int wr, int wc, int fr, int fq) const {
        const int row0 = u.pm * BM + wr * 64 + fr; int colt = u.pn * BM; bf16_t* base = O;
        float sc = 1.f; if (split_cols) { const int t = colt / split_cols; base += (size_t)t * split_stride; colt -= t * split_cols; if (t == 0) sc = scale0; }
        const int col0 = colt + wc * 32 + 8 * fq, bcol0 = u.pn * BM + wc * 32 + 8 * fq;
        f32x4 bv[2][2];
#pragma unroll
        for (int bj = 0; bj < 2; ++bj)
#pragma unroll
            for (int n = 0; n < 2; ++n) bv[bj][n] = bias ? *(const f32x4*)(bias + bcol0 + bj * HALF + 4 * n) : (f32x4){0.f, 0.f, 0.f, 0.f};
#pragma unroll
        for (int ai = 0; ai < 2; ++ai)
#pragma unroll
            for (int m = 0; m < 4; ++m) { bf16_t* rowp = base + (size_t)(row0 + ai * HALF + m * 16) * ldc + col0;
#pragma unroll
                for (int bj = 0; bj < 2; ++bj) { f32x4 v0 = acc[ai][bj][m][0] + bv[bj][0], v1 = acc[ai][bj][m][1] + bv[bj][1];
                    if (ACT == 1) { f32x2 a = gelu_pk((f32x2){v0[0], v0[1]}), b = gelu_pk((f32x2){v0[2], v0[3]}), c = gelu_pk((f32x2){v1[0], v1[1]}), d = gelu_pk((f32x2){v1[2], v1[3]});
                        v0 = (f32x4){a.x, a.y, b.x, b.y}; v1 = (f32x4){c.x, c.y, d.x, d.y}; }
                    v0 = v0 * sc; v1 = v1 * sc; u32x4 w; w.x = cvt_pk_bf16(v0[0], v0[1]); w.y = cvt_pk_bf16(v0[2], v0[3]); w.z = cvt_pk_bf16(v1[0], v1[1]); w.w = cvt_pk_bf16(v1[2], v1[3]);
                    *(u32x4*)(rowp + bj * HALF) = w; } }
    }
};
template <class Epi, class Sched, bool ALIGN_EPI = false, bool SP2 = false>
__device__ __forceinline__ void gemm_phase(PG8_LAS unsigned char* lds, const Gemm g, const Sched& S, const Epi& E) {
    const int tid = threadIdx.x, wid = __builtin_amdgcn_readfirstlane(tid >> 6), lane = tid & 63, wr = wid >> 2, wc = wid & 3, fr = lane & 15, fq = lane >> 4;
    const int K = g.K, nt = K / BK;
    unsigned voffA[2], voffB[2];
#pragma unroll
    for (int i = 0; i < 2; ++i) { int R, C; stage_rc(tid * 16 + i * 8192, R, C); const int Rb = Epi::PERM ? ((R & ~31) + perm32(R & 31)) : R;
        voffA[i] = (unsigned)(R * K + C) * 2u; voffB[i] = (unsigned)(Rb * K + C) * 2u; }
    const size_t kstep = (size_t)(BK * 2);
    const size_t hstep = (size_t)HALF * K * 2;
    const size_t tstep = 2 * hstep;
    const unsigned ldsw = (unsigned)wid * 1024u;
    const int aoff = lds_byte(wr * 64 + fr, fq * 8), boff = lds_byte(wc * 32 + fr, fq * 8);
#define PG8_SA(b, h) (((b) * 2 + (h)) * HTB)
#define PG8_SB(b, h) ((4 + (b) * 2 + (h)) * HTB)
#define PG8_STAGE(bufoff, gbase, voff) do { _Pragma("unroll") for (int _i = 0; _i < 2; ++_i) \
        __builtin_amdgcn_global_load_lds((const unsigned*)((const char*)(gbase) + (voff)[_i]), (PG8_LAS unsigned*)(lds + (bufoff) + ldsw + _i * 8192), 16, 0, 0); } while (0)
#define PG8_LDA(dst, b, h) do { _Pragma("unroll") for (int m = 0; m < 4; ++m) _Pragma("unroll") for (int k = 0; k < 2; ++k) dst[m][k] = *(const PG8_LAS bf16x8*)(lds + PG8_SA(b, h) + aoff + m * 2048 + k * 1024); } while (0)
#define PG8_LDB(dst, b, h) do { _Pragma("unroll") for (int n = 0; n < 2; ++n) _Pragma("unroll") for (int k = 0; k < 2; ++k) dst[n][k] = *(const PG8_LAS bf16x8*)(lds + PG8_SB(b, h) + boff + n * 2048 + k * 1024); } while (0)
#define PG8_MMA(ai, bj, At, Bt) do { __builtin_amdgcn_s_setprio(1); _Pragma("unroll") for (int m = 0; m < 4; ++m) _Pragma("unroll") for (int n = 0; n < 2; ++n) _Pragma("unroll") for (int k = 0; k < 2; ++k) \
        acc[ai][bj][m][n] = __builtin_amdgcn_mfma_f32_16x16x32_bf16(Bt[n][k], At[m][k], acc[ai][bj][m][n], 0, 0, 0); __builtin_amdgcn_s_setprio(0); } while (0)
#define PG8_WAIT_V(n) asm volatile("s_waitcnt vmcnt(" #n ")" ::: "memory")
#define PG8_WAIT_L(n) asm volatile("s_waitcnt lgkmcnt(" #n ")" ::: "memory")
#define PG8_BAR __builtin_amdgcn_s_barrier()
#define PG8_SCHED __builtin_amdgcn_sched_barrier(0)
    Unit cur, nxt; int ui = 0;
    if (!S.next(0, cur)) return;
    f32x4 acc[2][2][4][2];
#pragma unroll
    for (int a = 0; a < 2; ++a)
#pragma unroll
        for (int b = 0; b < 2; ++b)
#pragma unroll
            for (int m = 0; m < 4; ++m)
#pragma unroll
                for (int n = 0; n < 2; ++n) acc[a][b][m][n] = (f32x4){0.f, 0.f, 0.f, 0.f};
    bf16x8 At[4][2], B0[2][2], B1[2][2];
    const char* cA = (const char*)g.A + (size_t)cur.pm * tstep; const char* cB = (const char*)g.Bt + (size_t)cur.pn * tstep;
    S.a_ready(cur);
    if constexpr (SP2) {
        PG8_STAGE(PG8_SB(0, 0), cB, voffB); PG8_STAGE(PG8_SB(0, 1), cB + hstep, voffB); PG8_STAGE(PG8_SA(0, 0), cA, voffA); PG8_STAGE(PG8_SA(0, 1), cA + hstep, voffA);
        if (wr == 1) PG8_BAR;
        PG8_WAIT_V(2); PG8_BAR;
        PG8_STAGE(PG8_SB(1, 0), cB + kstep, voffB); PG8_STAGE(PG8_SA(1, 0), cA + kstep, voffA); PG8_STAGE(PG8_SB(1, 1), cB + hstep + kstep, voffB);
        PG8_WAIT_V(6); PG8_BAR;
    } else {
        PG8_STAGE(PG8_SB(0, 0), cB, voffB); PG8_STAGE(PG8_SA(0, 0), cA, voffA); PG8_STAGE(PG8_SB(0, 1), cB + hstep, voffB); PG8_STAGE(PG8_SA(0, 1), cA + hstep, voffA);
        if (wr == 1) PG8_BAR;
        PG8_WAIT_V(4); PG8_BAR;
        PG8_STAGE(PG8_SB(1, 0), cB + kstep, voffB); PG8_STAGE(PG8_SA(1, 0), cA + kstep, voffA); PG8_STAGE(PG8_SB(1, 1), cB + hstep + kstep, voffB);
        PG8_WAIT_V(6); PG8_BAR;
    }
    for (;;) {
        const bool has_next = S.next(ui + 1, nxt);
        const char* nA = has_next ? (const char*)g.A + (size_t)nxt.pm * tstep : cA; const char* nB = has_next ? (const char*)g.Bt + (size_t)nxt.pn * tstep : cB;
        for (int t = 0; t < nt; t += 2) {
            const bool last = (t == nt - 2);
            const char* a1 = cA + (size_t)(t + 1) * kstep;
            const char* a2 = last ? nA : cA + (size_t)(t + 2) * kstep; const char* b2 = last ? nB : cB + (size_t)(t + 2) * kstep;
            const char* a3 = a2 + kstep; const char* b3 = b2 + kstep;
            if (last && has_next) S.a_ready(nxt);
            if constexpr (SP2) {
            PG8_LDB(B0, 0, 0); PG8_LDB(B1, 0, 1); PG8_SCHED; PG8_LDA(At, 0, 0); PG8_STAGE(PG8_SA(1, 1), a1 + hstep, voffA);
            PG8_WAIT_V(8); PG8_WAIT_L(0); PG8_BAR; PG8_MMA(0, 0, At, B0); PG8_MMA(0, 1, At, B1); PG8_BAR; PG8_SCHED;
            PG8_LDA(At, 0, 1); PG8_STAGE(PG8_SB(0, 0), b2, voffB); PG8_STAGE(PG8_SB(0, 1), b2 + hstep, voffB); PG8_STAGE(PG8_SA(0, 0), a2, voffA);
            PG8_WAIT_V(8); PG8_WAIT_L(0); PG8_BAR; PG8_MMA(1, 0, At, B0); PG8_MMA(1, 1, At, B1); PG8_BAR; PG8_SCHED;
            PG8_LDB(B0, 1, 0); PG8_LDB(B1, 1, 1); PG8_SCHED; PG8_LDA(At, 1, 0); PG8_STAGE(PG8_SA(0, 1), a2 + hstep, voffA);
            PG8_WAIT_V(8); PG8_WAIT_L(0); PG8_BAR; PG8_MMA(0, 0, At, B0); PG8_MMA(0, 1, At, B1); PG8_BAR; PG8_SCHED;
            PG8_LDA(At, 1, 1); PG8_STAGE(PG8_SB(1, 0), b3, voffB); PG8_STAGE(PG8_SB(1, 1), b3 + hstep, voffB); PG8_STAGE(PG8_SA(1, 0), a3, voffA);
            PG8_WAIT_V(8); PG8_WAIT_L(0); PG8_BAR; PG8_MMA(1, 0, At, B0); PG8_MMA(1, 1, At, B1); PG8_BAR; PG8_SCHED;
            } else {
            PG8_LDB(B0, 0, 0); PG8_SCHED; PG8_LDA(At, 0, 0); PG8_STAGE(PG8_SA(1, 1), a1 + hstep, voffA);
            PG8_WAIT_L(8); PG8_BAR; PG8_WAIT_L(0); PG8_MMA(0, 0, At, B0); PG8_BAR; PG8_SCHED;
            PG8_LDB(B1, 0, 1); PG8_STAGE(PG8_SB(0, 0), b2, voffB);
            PG8_BAR; PG8_WAIT_L(0); PG8_MMA(0, 1, At, B1); PG8_BAR;
            PG8_LDA(At, 0, 1); PG8_STAGE(PG8_SA(0, 0), a2, voffA);
            PG8_BAR; PG8_WAIT_L(0); PG8_MMA(1, 0, At, B0); PG8_BAR; PG8_SCHED;
            PG8_STAGE(PG8_SB(0, 1), b2 + hstep, voffB);
            PG8_WAIT_V(6); PG8_BAR; PG8_MMA(1, 1, At, B1); PG8_BAR;
            PG8_LDB(B0, 1, 0); PG8_SCHED; PG8_LDA(At, 1, 0); PG8_STAGE(PG8_SA(0, 1), a2 + hstep, voffA);
            PG8_WAIT_L(8); PG8_BAR; PG8_WAIT_L(0); PG8_MMA(0, 0, At, B0); PG8_BAR; PG8_SCHED;
            PG8_LDB(B1, 1, 1); PG8_STAGE(PG8_SB(1, 0), b3, voffB);
            PG8_BAR; PG8_WAIT_L(0); PG8_MMA(0, 1, At, B1); PG8_BAR;
            PG8_LDA(At, 1, 1); PG8_STAGE(PG8_SA(1, 0), a3, voffA);
            PG8_BAR; PG8_WAIT_L(0); PG8_MMA(1, 0, At, B0); PG8_BAR; PG8_SCHED;
            PG8_STAGE(PG8_SB(1, 1), b3 + hstep, voffB);
            PG8_WAIT_V(6); PG8_BAR; PG8_MMA(1, 1, At, B1); PG8_BAR;
            }
        }
        if constexpr (ALIGN_EPI) { if (wr == 0) PG8_BAR; }
        if constexpr (!Epi::AFTER_DRAIN) { E(acc, cur, wr, wc, fr, fq); S.done(cur); }
        if (!has_next) break;
#pragma unroll
        for (int a = 0; a < 2; ++a)
#pragma unroll
            for (int b = 0; b < 2; ++b)
#pragma unroll
                for (int m = 0; m < 4; ++m)
#pragma unroll
                    for (int n = 0; n < 2; ++n) acc[a][b][m][n] = (f32x4){0.f, 0.f, 0.f, 0.f};
        cur = nxt; cA = nA; cB = nB; ++ui;
        if constexpr (ALIGN_EPI) { if (wr == 1) PG8_BAR; }
    }
    PG8_WAIT_V(0);
    if constexpr (!ALIGN_EPI) { if (wr == 0) PG8_BAR; }
    PG8_BAR;
    if constexpr (Epi::AFTER_DRAIN) { E.fused(acc, cur, wr, wc, fr, fq, lds, wid, lane); S.done(cur); }
#undef PG8_SA
#undef PG8_SB
#undef PG8_STAGE
#undef PG8_LDA
#undef PG8_LDB
#undef PG8_MMA
#undef PG8_WAIT_V
#undef PG8_WAIT_L
#undef PG8_BAR
#undef PG8_SCHED
}
}
#define GAS __attribute__((address_space(1)))
#define LAS __attribute__((address_space(3)))
typedef unsigned short bf16;
typedef unsigned v4u __attribute__((ext_vector_type(4)));
typedef float f32x4 __attribute__((ext_vector_type(4)));
typedef short bf16x8 __attribute__((ext_vector_type(8)));
typedef GAS unsigned gu32;
typedef GAS unsigned long long gu64;
#define RLX_AGENT __ATOMIC_RELAXED, __HIP_MEMORY_SCOPE_AGENT
#define LDS_WAIT() asm volatile("s_waitcnt lgkmcnt(0)" ::: "memory")
#define VM_WAIT() asm volatile("s_waitcnt vmcnt(0)" ::: "memory")
__device__ __forceinline__ unsigned long long rt() { return __builtin_amdgcn_s_memrealtime(); }
__device__ __forceinline__ unsigned f2bf(float f) { unsigned u = __builtin_bit_cast(unsigned, f); return (u + 0x7fffu + ((u >> 16) & 1u)) >> 16; }
__device__ __forceinline__ unsigned pk2(float lo, float hi) { return f2bf(lo) | (f2bf(hi) << 16); }
#define XB_TMO      128
#define XB_XCNT(j)  (256  + 64 * (j))
#define XB_XSUB(j)  (1280 + 64 * (j))
#define XB_XGEN(j)  (2304 + 64 * (j))
#define XB_TOP      3328
#define XB_TOPGEN   3392
#define XCD_BAR_WORDS 3456
#define XB_SPIN_CAP (1u << 18)

__device__ __forceinline__ unsigned xb_ld(unsigned* p)              { return __hip_atomic_load(p, __ATOMIC_RELAXED, __HIP_MEMORY_SCOPE_AGENT); }
__device__ __forceinline__ unsigned xb_add(unsigned* p, unsigned v) { return __hip_atomic_fetch_add(p, v, __ATOMIC_RELAXED, __HIP_MEMORY_SCOPE_AGENT); }
__device__ __forceinline__ unsigned xb_xcc_id() { return (unsigned)__builtin_amdgcn_s_getreg((3 << 11) | 20) & 0xFu; }
#define XB_SPIN(cond, bar) do { unsigned _sp = 0; while (cond) { __builtin_amdgcn_s_sleep(1); \
    if ((++_sp & 255u) == 0u) { if (xb_ld(&(bar)[XB_TMO])) break; if (_sp > XB_SPIN_CAP) { atomicAdd(&(bar)[XB_TMO], 1u); break; } } } } while (0)

struct XcdBarrier {
    unsigned* bar; unsigned x;
    volatile LAS unsigned* st;
};

__device__ __forceinline__ XcdBarrier xcd_barrier_post(unsigned* bar, volatile LAS unsigned* st) {
    XcdBarrier b; b.bar = bar; b.x = xb_xcc_id(); b.st = st;
    if (threadIdx.x == 0) (void)xb_add(&bar[XB_XCNT(b.x)], 1u);
    return b;
}
__device__ __forceinline__ void xcd_barrier_complete(unsigned* bar, unsigned x, unsigned& nloc, unsigned& nx) {
    const unsigned G = gridDim.x * gridDim.y * gridDim.z;
    unsigned sum, cnt, mine, sp = 0u;
    for (;;) {
        sum = 0u; cnt = 0u; mine = 0u;
#pragma unroll
        for (unsigned j = 0; j < 16; ++j) { const unsigned c = xb_ld(&bar[XB_XCNT(j)]); sum += c; cnt += (c > 0u) ? 1u : 0u; mine = (j == x) ? c : mine; }
        if (sum == G) break;
        __builtin_amdgcn_s_sleep(1);
        if ((++sp & 255u) == 0u) { if (xb_ld(&bar[XB_TMO])) break; if (sp > XB_SPIN_CAP) { atomicAdd(&bar[XB_TMO], 1u); break; } }
    }
    nloc = mine > 0u ? mine : 1u; nx = cnt > 0u ? cnt : 1u;
}

__device__ __forceinline__ void xcd_barrier(const XcdBarrier& b) {
    asm volatile("s_waitcnt vmcnt(0)" ::: "memory");
    __syncthreads();
    if (threadIdx.x == 0) {
        unsigned* bar = b.bar;
        __builtin_amdgcn_s_waitcnt(0);
        unsigned nloc = b.st[0], nx = b.st[1];
        if (nloc == 0u) { xcd_barrier_complete(bar, b.x, nloc, nx); b.st[0] = nloc; b.st[1] = nx; }
        const unsigned old = xb_add(&bar[XB_XSUB(b.x)], 1u);
        const unsigned gen = old / nloc;
        if (old + 1u == (gen + 1u) * nloc) {
            __builtin_amdgcn_fence(__ATOMIC_RELEASE, "agent");
            asm volatile("s_waitcnt vmcnt(0)" ::: "memory");
            const unsigned og = xb_add(&bar[XB_TOP], 1u);
            const unsigned tg = og / nx;
            if (og + 1u == (tg + 1u) * nx) xb_add(&bar[XB_TOPGEN], 1u);
            else XB_SPIN(xb_ld(&bar[XB_TOPGEN]) == tg, bar);
            __builtin_amdgcn_fence(__ATOMIC_ACQUIRE, "agent");
            xb_add(&bar[XB_XGEN(b.x)], 1u);
            asm volatile("s_waitcnt vmcnt(0)" ::: "memory");
        } else {
            XB_SPIN(xb_ld(&bar[XB_XGEN(b.x)]) == gen, bar);
            __builtin_amdgcn_fence(__ATOMIC_ACQUIRE, "agent");
            asm volatile("s_waitcnt vmcnt(0)" ::: "memory");
        }
    }
    __syncthreads();
}
typedef unsigned u32x4 __attribute__((ext_vector_type(4)));
__device__ __forceinline__ float wave_sum(float v) {
#pragma unroll
    for (int o = 1; o < 64; o <<= 1) v += __shfl_xor(v, o);
    return v;
}

constexpr int NWAVES = 8;
constexpr int MP = 16384, MS = 128, M = MP + MS, MPAD = 16640;
constexpr int SEQ = 8192;
constexpr int D = 1024, NPROJ = 4352, DATT = 512, DC = 512, FF = 2816;
constexpr int C_Q = 0, C_K = 512, C_V = 640, C_CB = 768, C_CC = 1280, C_CH = 1792, C_GA = 2304, C_GB = 3328;
constexpr float LN_EPS = 1e-5f;
constexpr float DN_ALPHA = 1.189207115002721f;
constexpr size_t O_YP = 0, O_YS = 16777216, O_KP = O_YS + 131072, O_VP = O_KP + 32768, O_CP = O_VP + 32768, O_FP = O_CP + 2048,
                 O_KS = O_FP + 11264, O_VS = O_KS + 2097152, O_CS = O_VS + 2097152, O_FS = O_CS + 131072, O_END = O_FS + 720896;
constexpr size_t MiB = 1u << 20;
constexpr size_t WS_CTL = 0, CTL_ZERO_BYTES = 64 * 1024;
constexpr size_t WS_WIN = 1 * MiB;
constexpr size_t WS_WAO = WS_WIN + (size_t)NPROJ * D * 2;
constexpr size_t WS_WCO = WS_WAO + (size_t)D * DATT * 2;
constexpr size_t WS_WMIX = WS_WCO + (size_t)D * DC * 2;
constexpr size_t WS_WGU = WS_WMIX + (size_t)D * D * 2;
constexpr size_t WS_WD = WS_WGU + (size_t)2 * FF * D * 2;
constexpr size_t WS_A = 32 * MiB;
constexpr size_t WS_B = WS_A + (size_t)MPAD * D * 2;
constexpr size_t WS_OATT = WS_B, WS_Z = WS_B + (size_t)MPAD * DATT * 2;
constexpr size_t WS_H2 = WS_A;
constexpr size_t WS_C = WS_B + (size_t)MPAD * D * 2;
constexpr size_t WS_P = WS_C;
constexpr size_t WS_X1 = WS_C;
constexpr size_t WS_H1 = WS_X1 + (size_t)MPAD * D * 2;
constexpr size_t WS_ACT = WS_H1;
constexpr size_t WS_HB = WS_C + (size_t)MPAD * NPROJ * 2;
constexpr size_t WS_END = WS_HB + (size_t)260 * 6 * FF * 4;
static_assert(WS_WD + (size_t)D * FF * 2 <= WS_A, "weights fit below 32 MiB");
static_assert(WS_ACT + (size_t)MPAD * FF * 2 <= WS_HB, "ACT fits in the P region");
static_assert(WS_END <= 256 * MiB, "workspace");
constexpr int CW_BAR = 1024;
constexpr int RING_BYTES = 131072, MISC_OFF = RING_BYTES, LDS_BYTES = RING_BYTES + 512;

using pg8::bf16_t; using pg8::Unit;
typedef unsigned u32x2 __attribute__((ext_vector_type(2)));
typedef float f32x16 __attribute__((ext_vector_type(16)));
constexpr int BM = 256, HALF = 128;

__device__ __forceinline__ float bf_lo(unsigned u) { return __uint_as_float(u << 16); }
__device__ __forceinline__ float bf_hi(unsigned u) { return __uint_as_float(u & 0xffff0000u); }
__device__ __forceinline__ float bf1(bf16_t h) { return __uint_as_float((unsigned)h << 16); }
__device__ __forceinline__ float sigm(float x) { return __builtin_amdgcn_rcpf(1.f + __expf(-x)); }
__device__ __forceinline__ unsigned cvtpk(float lo, float hi) { return pg8::cvt_pk_bf16(lo, hi); }
template <int CTRL> __device__ __forceinline__ float dppf(float x) { return __builtin_bit_cast(float, __builtin_amdgcn_update_dpp(0, __builtin_bit_cast(int, x), CTRL, 0xf, 0xf, false)); }
template <int CTRL> __device__ __forceinline__ f32x4 dpp4(f32x4 v) { f32x4 r; r[0] = dppf<CTRL>(v[0]); r[1] = dppf<CTRL>(v[1]); r[2] = dppf<CTRL>(v[2]); r[3] = dppf<CTRL>(v[3]); return r; }
__device__ __forceinline__ f32x4 gelu4(f32x4 v) { pg8::f32x2 a = pg8::gelu_pk((pg8::f32x2){v[0], v[1]}), b = pg8::gelu_pk((pg8::f32x2){v[2], v[3]}); return (f32x4){a.x, a.y, b.x, b.y}; }

template <int PASS> struct EpiGate {
    static constexpr bool PERM = true, AFTER_DRAIN = false;
    const bf16_t* P; bf16_t* MG;
    __device__ __forceinline__ void operator()(const f32x4 (&acc)[2][2][4][2], const Unit& u, int wr, int wc, int fr, int fq) const {
        const int row0 = u.pm * BM + wr * 64 + fr, col0 = u.pn * BM + wc * 32 + 8 * fq;
#pragma unroll
        for (int ai = 0; ai < 2; ++ai)
#pragma unroll
            for (int m = 0; m < 4; ++m) { const size_t row = (size_t)(row0 + ai * HALF + m * 16);
#pragma unroll
                for (int bj = 0; bj < 2; ++bj) { const int col = col0 + bj * HALF;
                    const u32x4 g = *(const u32x4*)(P + row * NPROJ + (PASS == 0 ? C_GA : C_GB) + col);
                    f32x4 v0 = acc[ai][bj][m][0], v1 = acc[ai][bj][m][1];
                    v0[0] *= sigm(bf_lo(g.x)); v0[1] *= sigm(bf_hi(g.x)); v0[2] *= sigm(bf_lo(g.y)); v0[3] *= sigm(bf_hi(g.y));
                    v1[0] *= sigm(bf_lo(g.z)); v1[1] *= sigm(bf_hi(g.z)); v1[2] *= sigm(bf_lo(g.w)); v1[3] *= sigm(bf_hi(g.w));
                    bf16_t* o = MG + row * D + col;
                    if (PASS == 1) { const u32x4 t = *(const u32x4*)o;
                        v0[0] += bf_lo(t.x); v0[1] += bf_hi(t.x); v0[2] += bf_lo(t.y); v0[3] += bf_hi(t.y);
                        v1[0] += bf_lo(t.z); v1[1] += bf_hi(t.z); v1[2] += bf_lo(t.w); v1[3] += bf_hi(t.w); }
                    u32x4 w; w.x = cvtpk(v0[0], v0[1]); w.y = cvtpk(v0[2], v0[3]); w.z = cvtpk(v1[0], v1[1]); w.w = cvtpk(v1[2], v1[3]);
                    *(u32x4*)o = w; } }
    }
};
struct EpiResX {
    static constexpr bool PERM = false, AFTER_DRAIN = false;
    const float* xp; const float* xs; float* H;
    __device__ __forceinline__ void operator()(const f32x4 (&acc)[2][2][4][2], const Unit& u, int wr, int wc, int fr, int fq) const {
#pragma unroll
        for (int ai = 0; ai < 2; ++ai) { const int rb = u.pm * BM + ai * HALF; if (rb >= M) continue;
            const float* xb = rb < MP ? xp + (size_t)rb * D : xs + (size_t)(rb - MP) * D; float* hb = H + (size_t)rb * D;
#pragma unroll
            for (int m = 0; m < 4; ++m) { const size_t ro = (size_t)(wr * 64 + m * 16 + fr) * D;
#pragma unroll
                for (int bj = 0; bj < 2; ++bj)
#pragma unroll
                    for (int n = 0; n < 2; ++n) { const int col = u.pn * BM + bj * HALF + wc * 32 + n * 16 + 4 * fq;
                        const f32x4 xv = *(const f32x4*)(xb + ro + col); *(f32x4*)(hb + ro + col) = xv * DN_ALPHA + acc[ai][bj][m][n]; } } }
    }
};
struct EpiResB {
    static constexpr bool PERM = false, AFTER_DRAIN = false;
    const bf16_t* X1; float* H;
    __device__ __forceinline__ void operator()(const f32x4 (&acc)[2][2][4][2], const Unit& u, int wr, int wc, int fr, int fq) const {
#pragma unroll
        for (int ai = 0; ai < 2; ++ai) { const int rb = u.pm * BM + ai * HALF; if (rb >= M) continue;
#pragma unroll
            for (int m = 0; m < 4; ++m) { const size_t ro = (size_t)(rb + wr * 64 + m * 16 + fr) * D;
#pragma unroll
                for (int bj = 0; bj < 2; ++bj)
#pragma unroll
                    for (int n = 0; n < 2; ++n) { const int col = u.pn * BM + bj * HALF + wc * 32 + n * 16 + 4 * fq;
                        const u32x2 xv = *(const u32x2*)(X1 + ro + col); const f32x4 x4 = {bf_lo(xv.x), bf_hi(xv.x), bf_lo(xv.y), bf_hi(xv.y)};
                        *(f32x4*)(H + ro + col) = x4 * DN_ALPHA + acc[ai][bj][m][n]; } } }
    }
};
struct EpiGU {
    static constexpr bool PERM = true, AFTER_DRAIN = false;
    bf16_t* ACT; float* HB; const float* cw; const float* stf; float* out;
    __device__ __forceinline__ void operator()(const f32x4 (&acc)[2][2][4][2], const Unit& u, int wr, int wc, int fr_, int fq_) const {
        int fr = fr_, fq = fq_; asm volatile("" : "+v"(fr), "+v"(fq));
#pragma unroll
        for (int n = 0; n < 2; ++n) {
            const int c0 = u.pn * HALF + wc * 32 + 8 * fq + 4 * n;
            const f32x4 w0 = *(const f32x4*)(cw + c0), w1 = *(const f32x4*)(cw + FF + c0), w2 = *(const f32x4*)(cw + 2 * FF + c0);
            if (u.pm < MP / BM) {
#pragma unroll
                for (int ai = 0; ai < 2; ++ai) { const int rbase = u.pm * BM + ai * HALF + wr * 64; const int G = rbase >> 6;
                    float* hb = HB + (size_t)G * 6 * FF + c0;
                    const bool lastg = ((rbase + 64) & (SEQ - 1)) == 0;
#pragma unroll
                    for (int m = 0; m < 4; ++m) { const size_t row = (size_t)(rbase + m * 16 + fr);
                        const f32x4 cur = acc[ai][0][m][n], upv = acc[ai][1][m][n];
                        f32x4 g1 = dpp4<0x121>(cur), g2 = dpp4<0x122>(cur);
                        if (m > 0) { const f32x4 p1 = dpp4<0x121>(acc[ai][0][m - 1][n]), p2 = dpp4<0x122>(acc[ai][0][m - 1][n]); if (fr < 1) g1 = p1; if (fr < 2) g2 = p2; }
                        const f32x4 a = gelu4(w0 * g2 + w1 * g1 + w2 * cur) * upv;
                        u32x2 w; w.x = cvtpk(a[0], a[1]); w.y = cvtpk(a[2], a[3]);
                        if (m == 0 && fr < 2) { *(f32x4*)(hb + (size_t)fr * FF) = cur; *(f32x4*)(hb + (size_t)(4 + fr) * FF) = upv; }
                        if (m == 3 && fr >= 14) { *(f32x4*)(hb + (size_t)(2 + fr - 14) * FF) = cur;
                            if (lastg) *(f32x4*)(out + O_FP + (size_t)((rbase >> 13) * 2 + fr - 14) * FF + c0) = cur; }
                        if (!(m == 0 && fr < 2)) *(u32x2*)(ACT + row * FF + c0) = w; } }
            } else {
#pragma unroll
                for (int m = 0; m < 4; ++m) { const int ns = wr * 64 + m * 16 + fr;
                    const f32x4 cur = acc[0][0][m][n], upv = acc[0][1][m][n];
                    const f32x4 g2 = *(const f32x4*)(stf + (size_t)(ns * 2 + 0) * FF + c0), g1 = *(const f32x4*)(stf + (size_t)(ns * 2 + 1) * FF + c0);
                    const f32x4 a = gelu4(w0 * g2 + w1 * g1 + w2 * cur) * upv;
                    u32x2 w; w.x = cvtpk(a[0], a[1]); w.y = cvtpk(a[2], a[3]);
                    *(f32x4*)(out + O_FS + (size_t)(ns * 2 + 0) * FF + c0) = g1; *(f32x4*)(out + O_FS + (size_t)(ns * 2 + 1) * FF + c0) = cur;
                    *(u32x2*)(ACT + (size_t)(MP + ns) * FF + c0) = w; }
            }
            __builtin_amdgcn_sched_barrier(0);
        }
    }
};

__device__ __forceinline__ void p0_item(const float* W, int K, int N, bf16* WT, int mode, LAS float* scr, int item, int lane) {
    const int nblk = N / 32, kb = item / nblk, nb = item % nblk, k0 = 64 * kb, n0 = 32 * nb;
    const int drow = mode == 0 ? n0 : 256 * (n0 >> 7) + (n0 & 127) + (mode == 2 ? 128 : 0);
#pragma unroll 8
    for (int i = 0; i < 32; ++i) { const int kk = 2 * i + (lane >> 5); scr[kk * 33 + (lane & 31)] = W[(size_t)(k0 + kk) * N + n0 + (lane & 31)]; }
    LDS_WAIT(); asm volatile("" ::: "memory");
    const int c = lane & 7;
#pragma unroll
    for (int j = 0; j < 4; ++j) { const int n = (lane >> 3) + 8 * j; const LAS float* s = scr + (8 * c) * 33 + n;
        v4u o; o.x = pk2(s[0 * 33], s[1 * 33]); o.y = pk2(s[2 * 33], s[3 * 33]); o.z = pk2(s[4 * 33], s[5 * 33]); o.w = pk2(s[6 * 33], s[7 * 33]);
        *(GAS v4u*)(WT + (size_t)(drow + n) * K + k0 + 8 * c) = o; }
    LDS_WAIT(); asm volatile("" ::: "memory");
}
struct In { const float *xp, *xs, *ck, *cv, *stc, *stf, *w_in, *conv_w, *sinks, *w_ao, *w_co, *w_mix, *ln1g, *ln1b, *w_gate, *w_up, *fcw, *w_down, *ln2g, *ln2b; };

__device__ __forceinline__ void p0_prologue(const In& I, unsigned char* ws, LAS unsigned char* lds, int gw, int NGW, int wave, int lane) {
    LAS float* scr = (LAS float*)(lds + wave * 16384);
    constexpr int I_IN = (D / 64) * (NPROJ / 32), I_AO = (DATT / 64) * (D / 32), I_MIX = (D / 64) * (D / 32), I_G = (D / 64) * (FF / 32), I_D = (FF / 64) * (D / 32);
    constexpr int NITEMS = I_IN + 2 * I_AO + I_MIX + 2 * I_G + I_D;
    for (int it = gw; it < NITEMS; it += NGW) {
        int r = it;
        if (r < I_IN) { p0_item(I.w_in, D, NPROJ, (bf16*)(ws + WS_WIN), 0, scr, r, lane); continue; } r -= I_IN;
        if (r < I_AO) { p0_item(I.w_ao, DATT, D, (bf16*)(ws + WS_WAO), 0, scr, r, lane); continue; } r -= I_AO;
        if (r < I_AO) { p0_item(I.w_co, DC, D, (bf16*)(ws + WS_WCO), 0, scr, r, lane); continue; } r -= I_AO;
        if (r < I_MIX) { p0_item(I.w_mix, D, D, (bf16*)(ws + WS_WMIX), 0, scr, r, lane); continue; } r -= I_MIX;
        if (r < I_G) { p0_item(I.w_gate, D, FF, (bf16*)(ws + WS_WGU), 1, scr, r, lane); continue; } r -= I_G;
        if (r < I_G) { p0_item(I.w_up, D, FF, (bf16*)(ws + WS_WGU), 2, scr, r, lane); continue; } r -= I_G;
        p0_item(I.w_down, FF, D, (bf16*)(ws + WS_WD), 0, scr, r, lane);
    }
    bf16* XB = (bf16*)(ws + WS_A);
    for (int m = gw; m < MPAD; m += NGW) {
        GAS unsigned long long* o8 = (GAS unsigned long long*)(XB + (size_t)m * D) + lane;
        if (m < M) { const float* xr = m < MP ? I.xp + (size_t)m * D : I.xs + (size_t)(m - MP) * D; const GAS f32x4* x4 = (const GAS f32x4*)xr + lane;
#pragma unroll
            for (int j = 0; j < 4; ++j) { const f32x4 v = x4[64 * j]; o8[64 * j] = (unsigned long long)pk2(v.x, v.y) | ((unsigned long long)pk2(v.z, v.w) << 32); }
        } else {
#pragma unroll
            for (int j = 0; j < 4; ++j) o8[64 * j] = 0ull;
        }
    }
}

typedef short s16x8 __attribute__((ext_vector_type(8)));
__device__ __forceinline__ void attn_prompt_unit(LAS unsigned char* lds, const bf16_t* P, bf16_t* OA, const float* sinks, int b, int i, int kvh, int tid) {
    LAS bf16_t* Ks = (LAS bf16_t*)lds;
    LAS bf16_t* VT = (LAS bf16_t*)(lds + 36864);
    const int lane = tid & 63, w = tid >> 6, l31 = lane & 31, hi = lane >> 5;
    const long rowbase = (long)b * SEQ + (long)(i - 1) * 128;
#pragma unroll
    for (int it = 0; it < 4; ++it) { const int ch = tid + it * 512, j = ch >> 3, c = ch & 7;
        const int jj = (i == 0 && j < 128) ? j + 128 : j;
        const bf16_t* src = P + (size_t)(rowbase + jj) * NPROJ + C_K + kvh * 64 + c * 8;
        const u32x4 kv = *(const u32x4*)src; const u32x4 vv = *(const u32x4*)(src + (C_V - C_K));
        *(LAS u32x4*)(Ks + j * 72 + c * 8) = kv;
        LAS bf16_t* vt = VT + (c * 8) * 260 + j;
        vt[0 * 260] = (bf16_t)(vv.x & 0xffffu); vt[1 * 260] = (bf16_t)(vv.x >> 16); vt[2 * 260] = (bf16_t)(vv.y & 0xffffu); vt[3 * 260] = (bf16_t)(vv.y >> 16);
        vt[4 * 260] = (bf16_t)(vv.z & 0xffffu); vt[5 * 260] = (bf16_t)(vv.z >> 16); vt[6 * 260] = (bf16_t)(vv.w & 0xffffu); vt[7 * 260] = (bf16_t)(vv.w >> 16); }
    __syncthreads();
    const int g = w >> 1, h = kvh * 4 + g;
    const float slope = exp2f(-(float)(h + 1)), sink = sinks[h];
#pragma unroll 1
    for (int t = 0; t < 2; ++t) {
        const int a0 = 64 * (w & 1) + 32 * t;
        const size_t qrow = (size_t)b * SEQ + (size_t)i * 128 + a0 + l31;
        s16x8 Bq[4];
#pragma unroll
        for (int s = 0; s < 4; ++s) Bq[s] = *(const s16x8*)(P + qrow * NPROJ + C_Q + h * 64 + 16 * s + 8 * hi);
        f32x16 S[5];
#pragma unroll
        for (int jt = 0; jt < 5; ++jt) {
#pragma unroll
            for (int r = 0; r < 16; ++r) S[jt][r] = 0.f;
#pragma unroll
            for (int s = 0; s < 4; ++s) { const s16x8 A = *(const LAS s16x8*)(Ks + (a0 + 32 * jt + l31) * 72 + 16 * s + 8 * hi);
                S[jt] = __builtin_amdgcn_mfma_f32_32x32x16_bf16(A, Bq[s], S[jt], 0, 0, 0); }
            __builtin_amdgcn_sched_barrier(0); }
        float mx = -1e30f;
        float basef = (float)(128 + l31 - 4 * hi), ubf = (i > 0) ? 128.f : fminf(128.f, (float)(l31 + a0));
        asm volatile("" : "+v"(basef), "+v"(ubf));
#pragma unroll
        for (int jt = 0; jt < 5; ++jt) {
#pragma unroll
            for (int r = 0; r < 16; ++r) { const float dist = basef - (float)(32 * jt + (r & 3) + 8 * (r >> 2));
                const bool valid = (dist >= 0.f) && (dist <= ubf);
                const float sv = valid ? S[jt][r] * 0.125f - slope * dist : -1e30f; S[jt][r] = sv; mx = fmaxf(mx, sv); }
            __builtin_amdgcn_sched_barrier(0); }
        mx = fmaxf(mx, __shfl_xor(mx, 32)); mx = fmaxf(mx, sink);
        float sum = 0.f;
#pragma unroll
        for (int jt = 0; jt < 5; ++jt) {
#pragma unroll
            for (int r = 0; r < 16; ++r) { const float p = __expf(S[jt][r] - mx); S[jt][r] = p; sum += p; }
            __builtin_amdgcn_sched_barrier(0); }
        sum += __shfl_xor(sum, 32);
        const float inv = 1.f / (sum + __expf(sink - mx));
        f32x16 O[2];
#pragma unroll
        for (int dt = 0; dt < 2; ++dt)
#pragma unroll
            for (int r = 0; r < 16; ++r) O[dt][r] = 0.f;
#pragma unroll
        for (int jt = 0; jt < 5; ++jt)
#pragma unroll
            for (int s2 = 0; s2 < 2; ++s2) {
                u32x4 pb; pb.x = cvtpk(S[jt][8 * s2 + 0], S[jt][8 * s2 + 1]); pb.y = cvtpk(S[jt][8 * s2 + 2], S[jt][8 * s2 + 3]); pb.z = cvtpk(S[jt][8 * s2 + 4], S[jt][8 * s2 + 5]); pb.w = cvtpk(S[jt][8 * s2 + 6], S[jt][8 * s2 + 7]);
                const s16x8 Bp = __builtin_bit_cast(s16x8, pb);
                const int kb = a0 + 32 * jt + 16 * s2 + 4 * hi;
#pragma unroll
                for (int dt = 0; dt < 2; ++dt) { const LAS bf16_t* vp = VT + (32 * dt + l31) * 260 + kb;
                    u32x4 av; const u32x2 lo = *(const LAS u32x2*)vp, hi2 = *(const LAS u32x2*)(vp + 8); av.x = lo.x; av.y = lo.y; av.z = hi2.x; av.w = hi2.y;
                    O[dt] = __builtin_amdgcn_mfma_f32_32x32x16_bf16(__builtin_bit_cast(s16x8, av), Bp, O[dt], 0, 0, 0); }
                __builtin_amdgcn_sched_barrier(0); }
        bf16_t* orow = OA + qrow * DATT + h * 64;
#pragma unroll
        for (int dt = 0; dt < 2; ++dt)
#pragma unroll
            for (int gq = 0; gq < 4; ++gq) { u32x2 o; o.x = cvtpk(O[dt][4 * gq + 0] * inv, O[dt][4 * gq + 1] * inv); o.y = cvtpk(O[dt][4 * gq + 2] * inv, O[dt][4 * gq + 3] * inv);
                *(u32x2*)(orow + 32 * dt + 8 * gq + 4 * hi) = o; }
    }
    __syncthreads();
}
__device__ __forceinline__ void attn_sample_unit(LAS unsigned char* lds, const bf16_t* P, bf16_t* OA, const float* ck, const float* cv, const float* sinks, float* out, int n, int kvh, int tid) {
    LAS float* Ks = (LAS float*)lds;
    LAS float* Vs = (LAS float*)(lds + 33792);
    LAS float* qs = (LAS float*)(lds + 67584);
    LAS float* sc = (LAS float*)(lds + 68608);
    const int lane = tid & 63, w = tid >> 6;
#pragma unroll
    for (int it = 0; it < 4; ++it) { const int idx = tid + it * 512, s = idx >> 4, c4 = (idx & 15) * 4;
        const size_t off = ((size_t)(n * 128 + s) * 2 + kvh) * 64 + c4;
        const f32x4 kk = *(const f32x4*)(ck + off), vv = *(const f32x4*)(cv + off);
        Ks[s * 65 + c4 + 0] = kk.x; Ks[s * 65 + c4 + 1] = kk.y; Ks[s * 65 + c4 + 2] = kk.z; Ks[s * 65 + c4 + 3] = kk.w;
        Vs[s * 65 + c4 + 0] = vv.x; Vs[s * 65 + c4 + 1] = vv.y; Vs[s * 65 + c4 + 2] = vv.z; Vs[s * 65 + c4 + 3] = vv.w;
        if (s >= 1) { *(f32x4*)(out + O_KS + off - 128) = kk; *(f32x4*)(out + O_VS + off - 128) = vv; } }
    const bf16_t* prow = P + (size_t)(MP + n) * NPROJ;
    if (tid < 64) { const float kn = bf1(prow[C_K + kvh * 64 + tid]), vn = bf1(prow[C_V + kvh * 64 + tid]);
        Ks[128 * 65 + tid] = kn; Vs[128 * 65 + tid] = vn;
        const size_t off = ((size_t)(n * 128 + 127) * 2 + kvh) * 64 + tid; out[O_KS + off] = kn; out[O_VS + off] = vn; }
    if (tid < 256) qs[tid] = bf1(prow[C_Q + kvh * 256 + tid]);
    __syncthreads();
    for (int idx = tid; idx < 4 * 129; idx += 512) { const int g = idx / 129, s = idx - g * 129; float dot = 0.f;
#pragma unroll 8
        for (int d = 0; d < 64; ++d) dot += qs[g * 64 + d] * Ks[s * 65 + d];
        sc[g * 132 + s] = dot * 0.125f - exp2f(-(float)(kvh * 4 + g + 1)) * (float)(128 - s); }
    __syncthreads();
    if (w < 4) { const float sink = sinks[kvh * 4 + w];
        const float s0 = sc[w * 132 + lane], s1 = sc[w * 132 + 64 + lane], s2 = lane == 0 ? sc[w * 132 + 128] : -1e30f;
        float mx = fmaxf(fmaxf(s0, s1), s2);
#pragma unroll
        for (int o = 1; o < 64; o <<= 1) mx = fmaxf(mx, __shfl_xor(mx, o));
        mx = fmaxf(mx, sink);
        const float p0 = __expf(s0 - mx), p1 = __expf(s1 - mx), p2 = lane == 0 ? __expf(s2 - mx) : 0.f;
        float sum = p0 + p1 + p2;
#pragma unroll
        for (int o = 1; o < 64; o <<= 1) sum += __shfl_xor(sum, o);
        const float inv = 1.f / (sum + __expf(sink - mx));
        sc[w * 132 + lane] = p0 * inv; sc[w * 132 + 64 + lane] = p1 * inv; if (lane == 0) sc[w * 132 + 128] = p2 * inv; }
    __syncthreads();
    if (tid < 256) { const int g = tid >> 6, d = tid & 63; float o = 0.f;
#pragma unroll 4
        for (int s = 0; s < 129; ++s) o += sc[g * 132 + s] * Vs[s * 65 + d];
        OA[(size_t)(MP + n) * DATT + (kvh * 4 + g) * 64 + d] = (bf16_t)(cvtpk(o, 0.f) & 0xffffu); }
    __syncthreads();
}
__device__ __forceinline__ void unpack8(const u32x4 v, float (&f)[8]) { f[0] = bf_lo(v.x); f[1] = bf_hi(v.x); f[2] = bf_lo(v.y); f[3] = bf_hi(v.y); f[4] = bf_lo(v.z); f[5] = bf_hi(v.z); f[6] = bf_lo(v.w); f[7] = bf_hi(v.w); }
__device__ __forceinline__ void conv_phase(const bf16_t* P, bf16_t* Z, const float* cw, const float* stc, float* out, int gtid, int NT) {
    for (int item = gtid; item < M * 64; item += NT) { const int r = item >> 6, c = (item & 63) * 8;
        const bf16_t* pr = P + (size_t)r * NPROJ;
        float cb[8], u0[8], u1[8], u2[8], t0[8], t1[8];
        unpack8(*(const u32x4*)(pr + C_CB + c), cb); unpack8(*(const u32x4*)(pr + C_CC + c), t0); unpack8(*(const u32x4*)(pr + C_CH + c), t1);
#pragma unroll
        for (int e = 0; e < 8; ++e) u0[e] = t0[e] * t1[e];
        if (r < MP) { const int t = r & (SEQ - 1);
            if (t >= 1) { unpack8(*(const u32x4*)(pr - NPROJ + C_CC + c), t0); unpack8(*(const u32x4*)(pr - NPROJ + C_CH + c), t1);
#pragma unroll
                for (int e = 0; e < 8; ++e) u1[e] = t0[e] * t1[e]; }
            else {
#pragma unroll
                for (int e = 0; e < 8; ++e) u1[e] = 0.f; }
            if (t >= 2) { unpack8(*(const u32x4*)(pr - 2 * NPROJ + C_CC + c), t0); unpack8(*(const u32x4*)(pr - 2 * NPROJ + C_CH + c), t1);
#pragma unroll
                for (int e = 0; e < 8; ++e) u2[e] = t0[e] * t1[e]; }
            else {
#pragma unroll
                for (int e = 0; e < 8; ++e) u2[e] = 0.f; }
            if (t >= SEQ - 2) { float* o = out + O_CP + (size_t)((r >> 13) * 2 + (t - (SEQ - 2))) * DC + c;
                *(f32x4*)o = (f32x4){u0[0], u0[1], u0[2], u0[3]}; *(f32x4*)(o + 4) = (f32x4){u0[4], u0[5], u0[6], u0[7]}; }
        } else { const int ns = r - MP; const float* s0 = stc + (size_t)(ns * 2) * DC + c; const float* s1 = s0 + DC;
            const f32x4 a0 = *(const f32x4*)s0, a1 = *(const f32x4*)(s0 + 4), b0 = *(const f32x4*)s1, b1 = *(const f32x4*)(s1 + 4);
            u2[0] = a0.x; u2[1] = a0.y; u2[2] = a0.z; u2[3] = a0.w; u2[4] = a1.x; u2[5] = a1.y; u2[6] = a1.z; u2[7] = a1.w;
            u1[0] = b0.x; u1[1] = b0.y; u1[2] = b0.z; u1[3] = b0.w; u1[4] = b1.x; u1[5] = b1.y; u1[6] = b1.z; u1[7] = b1.w;
            float* o = out + O_CS + (size_t)(ns * 2) * DC + c;
            *(f32x4*)o = b0; *(f32x4*)(o + 4) = b1; *(f32x4*)(o + DC) = (f32x4){u0[0], u0[1], u0[2], u0[3]}; *(f32x4*)(o + DC + 4) = (f32x4){u0[4], u0[5], u0[6], u0[7]}; }
        float z[8];
#pragma unroll
        for (int e = 0; e < 8; ++e) z[e] = cb[e] * (cw[c + e] * u2[e] + cw[DC + c + e] * u1[e] + cw[2 * DC + c + e] * u0[e]);
        u32x4 w; w.x = cvtpk(z[0], z[1]); w.y = cvtpk(z[2], z[3]); w.z = cvtpk(z[4], z[5]); w.w = cvtpk(z[6], z[7]);
        *(u32x4*)(Z + (size_t)r * DC + c) = w; }
    for (int item = gtid; item < 2 * 128 * 32; item += NT) { const int b = item >> 12, i = (item >> 5) & 127, c8 = (item & 31) * 8;
        float f[8]; unpack8(*(const u32x4*)(P + (size_t)(b * SEQ + SEQ - 128 + i) * NPROJ + C_K + c8), f);
        float* o = (c8 < 128 ? out + O_KP + (size_t)(b * 128 + i) * 128 + c8 : out + O_VP + (size_t)(b * 128 + i) * 128 + (c8 - 128));
        *(f32x4*)o = (f32x4){f[0], f[1], f[2], f[3]}; *(f32x4*)(o + 4) = (f32x4){f[4], f[5], f[6], f[7]}; }
}

template <bool OUT_BF16> __device__ __forceinline__ void ln_phase(const float* H, const float* gam, const float* bet, bf16_t* Xo, float* out, int gw, int NGW, int lane) {
    f32x4 g4[4], b4[4];
#pragma unroll
    for (int j = 0; j < 4; ++j) { g4[j] = ((const f32x4*)gam)[lane + 64 * j]; b4[j] = ((const f32x4*)bet)[lane + 64 * j]; }
    for (int m = gw; m < M; m += NGW) {
        const f32x4* xr = (const f32x4*)(H + (size_t)m * D) + lane;
        f32x4 v[4]; float s = 0.f;
#pragma unroll
        for (int j = 0; j < 4; ++j) { v[j] = xr[64 * j]; s += (v[j].x + v[j].y) + (v[j].z + v[j].w); }
        const float mean = wave_sum(s) * (1.f / D); float s2 = 0.f;
#pragma unroll
        for (int j = 0; j < 4; ++j) { v[j] = v[j] - mean; s2 += (v[j].x * v[j].x + v[j].y * v[j].y) + (v[j].z * v[j].z + v[j].w * v[j].w); }
        const float rstd = 1.f / sqrtf(wave_sum(s2) * (1.f / D) + LN_EPS);
        if (OUT_BF16) { unsigned long long* o8 = (unsigned long long*)(Xo + (size_t)m * D) + lane;
#pragma unroll
            for (int j = 0; j < 4; ++j) { const f32x4 y = v[j] * rstd * g4[j] + b4[j]; o8[64 * j] = (unsigned long long)cvtpk(y.x, y.y) | ((unsigned long long)cvtpk(y.z, y.w) << 32); }
        } else { f32x4* o = (f32x4*)(m < MP ? out + O_YP + (size_t)m * D : out + O_YS + (size_t)(m - MP) * D) + lane;
#pragma unroll
            for (int j = 0; j < 4; ++j) o[64 * j] = v[j] * rstd * g4[j] + b4[j]; }
    }
}
__device__ __forceinline__ void halo_phase(const float* HB, const float* cw, bf16_t* ACT, int gtid, int NT) {
    constexpr int C4 = FF / 4;
    for (int item = gtid; item < (MP / 64) * 2 * C4; item += NT) { const int c4 = (item % C4) * 4, rr = item / C4, G = rr >> 1, j = rr & 1;
        const float* hb = HB + (size_t)G * 6 * FF + c4; const bool first = (G & 127) == 0;
        const f32x4 z = {0.f, 0.f, 0.f, 0.f};
        const f32x4 g0 = *(const f32x4*)hb, pl1 = first ? z : *(const f32x4*)(hb - 6 * FF + 3 * FF);
        f32x4 cur, gm1, gm2, upv;
        if (j == 0) { cur = g0; gm1 = pl1; gm2 = first ? z : *(const f32x4*)(hb - 6 * FF + 2 * FF); upv = *(const f32x4*)(hb + 4 * FF); }
        else { cur = *(const f32x4*)(hb + FF); gm1 = g0; gm2 = pl1; upv = *(const f32x4*)(hb + 5 * FF); }
        const f32x4 w0 = *(const f32x4*)(cw + c4), w1 = *(const f32x4*)(cw + FF + c4), w2 = *(const f32x4*)(cw + 2 * FF + c4);
        const f32x4 a = gelu4(w0 * gm2 + w1 * gm1 + w2 * cur) * upv;
        u32x2 w; w.x = cvtpk(a[0], a[1]); w.y = cvtpk(a[2], a[3]);
        *(u32x2*)(ACT + (size_t)(64 * G + j) * FF + c4) = w; }
}

#ifndef MK_N_LAUNCHES
#define MK_N_LAUNCHES 1
#endif
constexpr int NPH = 10;
struct Args { const float* in[20]; float* out; unsigned char* ws; int ph_lo, ph_hi, never, pad; };
__global__ void __launch_bounds__(NWAVES * 64, 2) fwd_kernel(Args args) {
    extern __shared__ __attribute__((aligned(16))) unsigned char lds_raw[];
    LAS unsigned char* lds = (LAS unsigned char*)lds_raw;
    volatile LAS unsigned* MISC = (volatile LAS unsigned*)(lds + MISC_OFF);
    const int tid = threadIdx.x, lane = tid & 63, wave = __builtin_amdgcn_readfirstlane(tid >> 6);
    const int G = gridDim.x, bx = blockIdx.x;
    const int gw = bx * NWAVES + wave, NGW = G * NWAVES, gtid = bx * (NWAVES * 64) + tid, NT = G * NWAVES * 64;
    unsigned char* ws = args.ws; float* out = args.out;
    In I; I.xp = args.in[0]; I.xs = args.in[1]; I.ck = args.in[2]; I.cv = args.in[3]; I.stc = args.in[4]; I.stf = args.in[5]; I.w_in = args.in[6]; I.conv_w = args.in[7]; I.sinks = args.in[8];
    I.w_ao = args.in[9]; I.w_co = args.in[10]; I.w_mix = args.in[11]; I.ln1g = args.in[12]; I.ln1b = args.in[13]; I.w_gate = args.in[14]; I.w_up = args.in[15]; I.fcw = args.in[16]; I.w_down = args.in[17];
    I.ln2g = args.in[18]; I.ln2b = args.in[19];
    if (args.never) cg::this_grid().sync();
    for (int u = tid; u < (LDS_BYTES - MISC_OFF) / 4; u += NWAVES * 64) ((LAS unsigned*)(lds + MISC_OFF))[u] = 0u;
    __syncthreads();
    const int lo = args.ph_lo, hi = args.ph_hi;
    const bool multi = (hi - lo) > 1;
    XcdBarrier bar; bar.bar = (unsigned*)(ws + WS_CTL) + CW_BAR; bar.x = 0; bar.st = nullptr;
    if (multi) bar = xcd_barrier_post((unsigned*)(ws + WS_CTL) + CW_BAR, MISC + 8);
#ifndef PH_MASK
#define PH_MASK 0x3ff
#endif
#define IN(k) (((PH_MASK >> (k)) & 1) && lo <= (k) && (k) < hi)
#define SEAM(k) do { if (IN(k) && IN((k) + 1)) xcd_barrier(bar); } while (0)
    bf16_t* const XB = (bf16_t*)(ws + WS_A); bf16_t* const MG = (bf16_t*)(ws + WS_A); bf16_t* const OATT = (bf16_t*)(ws + WS_OATT); bf16_t* const Z = (bf16_t*)(ws + WS_Z);
    bf16_t* const P = (bf16_t*)(ws + WS_P); bf16_t* const X1 = (bf16_t*)(ws + WS_X1); float* const H1 = (float*)(ws + WS_H1); bf16_t* const ACT = (bf16_t*)(ws + WS_ACT);
    float* const H2 = (float*)(ws + WS_H2); float* const HB = (float*)(ws + WS_HB);

    if (IN(0)) { p0_prologue(I, ws, lds, gw, NGW, wave, lane); }
    SEAM(0);
    if (IN(1)) {
        pg8::Gemm g{XB, (const bf16_t*)(ws + WS_WIN), MPAD, NPROJ, D}; pg8::StaticOrder S; S.init(MPAD, NPROJ, G, bx);
        pg8::EpiBf16<0> E{P, NPROJ, nullptr, 0, 0, 1.f};
        pg8::gemm_phase<pg8::EpiBf16<0>, pg8::StaticOrder, true, true>(lds, g, S, E);
    }
    SEAM(1);
    if (IN(2)) {
        for (int un = bx; un < 512; un += G) {
#ifndef NO_AP
            if (un < 256) attn_prompt_unit(lds, P, OATT, I.sinks, un >> 7, (un >> 1) & 63, un & 1, tid);
#endif
#ifndef NO_AS
            if (un >= 256) attn_sample_unit(lds, P, OATT, I.ck, I.cv, I.sinks, out, (un - 256) >> 1, un & 1, tid);
#endif
        }
#ifndef NO_CV
        conv_phase(P, Z, I.conv_w, I.stc, out, gtid, NT);
#endif
    }
    SEAM(2);
    if (IN(3)) {
        pg8::StaticOrder S; S.init(MPAD, D, G, bx);
        { pg8::Gemm g{OATT, (const bf16_t*)(ws + WS_WAO), MPAD, D, DATT}; EpiGate<0> E{P, MG}; pg8::gemm_phase<EpiGate<0>, pg8::StaticOrder, true, true>(lds, g, S, E); }
        { pg8::Gemm g{Z, (const bf16_t*)(ws + WS_WCO), MPAD, D, DC}; EpiGate<1> E{P, MG}; pg8::gemm_phase<EpiGate<1>, pg8::StaticOrder, true, true>(lds, g, S, E); }
    }
    SEAM(3);
    if (IN(4)) {
        pg8::Gemm g{MG, (const bf16_t*)(ws + WS_WMIX), MPAD, D, D}; pg8::StaticOrder S; S.init(MPAD, D, G, bx);
        EpiResX E{I.xp, I.xs, H1}; pg8::gemm_phase<EpiResX, pg8::StaticOrder, true, true>(lds, g, S, E);
    }
    SEAM(4);
    if (IN(5)) ln_phase<true>(H1, I.ln1g, I.ln1b, X1, nullptr, gw, NGW, lane);
    SEAM(5);
    if (IN(6)) {
        pg8::Gemm g{X1, (const bf16_t*)(ws + WS_WGU), MPAD, 2 * FF, D}; pg8::StaticOrder S; S.init(MPAD, 2 * FF, G, bx);
        EpiGU E{ACT, HB, I.fcw, I.stf, out}; pg8::gemm_phase<EpiGU, pg8::StaticOrder, true, true>(lds, g, S, E);
    }
    SEAM(6);
    if (IN(7)) halo_phase(HB, I.fcw, ACT, gtid, NT);
    SEAM(7);
    if (IN(8)) {
        pg8::Gemm g{ACT, (const bf16_t*)(ws + WS_WD), MPAD, D, FF}; pg8::StaticOrder S; S.init(MPAD, D, G, bx);
        EpiResB E{X1, H2}; pg8::gemm_phase<EpiResB, pg8::StaticOrder, true, true>(lds, g, S, E);
    }
    SEAM(8);
    if (IN(9)) ln_phase<false>(H2, I.ln2g, I.ln2b, nullptr, out, gw, NGW, lane);
#undef IN
#undef SEAM
}

extern "C" void kernel_launch(void* const* d_in, const int* in_sizes, int n_in, void* d_out, int out_size, void* d_ws, size_t ws_size, hipStream_t stream) {
    static int grid = 0;
    if (grid == 0) {
        if (n_in != 20 || (size_t)out_size != O_END || ws_size < WS_END) { fprintf(stderr, "kernel_launch: unexpected shapes: n_in %d out %d ws %zu (need %zu)\n", n_in, out_size, ws_size, (size_t)WS_END); grid = -1; return; }
        int dev = 0, cus = 0, per_cu = 0;
        if (hipGetDevice(&dev) != hipSuccess || hipDeviceGetAttribute(&cus, hipDeviceAttributeMultiprocessorCount, dev) != hipSuccess) { grid = -1; return; }
        if (hipFuncSetAttribute((const void*)fwd_kernel, hipFuncAttributeMaxDynamicSharedMemorySize, LDS_BYTES) != hipSuccess) { fprintf(stderr, "kernel_launch: hipFuncSetAttribute failed\n"); grid = -1; return; }
        if (hipOccupancyMaxActiveBlocksPerMultiprocessor(&per_cu, (const void*)fwd_kernel, NWAVES * 64, LDS_BYTES) != hipSuccess || per_cu < 1) { fprintf(stderr, "kernel_launch: occupancy query says %d\n", per_cu); per_cu = 1; }
        (void)hipGetLastError();
        grid = cus;
    }
    if (grid < 0) return;
    (void)hipMemsetAsync((char*)d_ws + WS_CTL, 0, CTL_ZERO_BYTES, stream);
    Args a{};
    for (int i = 0; i < 20; ++i) a.in[i] = (const float*)d_in[i];
    a.out = (float*)d_out; a.ws = (unsigned char*)d_ws; a.never = 0; a.pad = 0;
#if MK_N_LAUNCHES == 1
    a.ph_lo = 0; a.ph_hi = NPH;
    void* kargs[] = {&a};
    hipError_t e = hipLaunchCooperativeKernel((const void*)fwd_kernel, dim3(grid), dim3(NWAVES * 64), kargs, LDS_BYTES, stream);
    if (e != hipSuccess) fprintf(stderr, "kernel_launch: cooperative launch failed: %s (grid %d)\n", hipGetErrorString(e), grid);
#else
    for (int k = 0; k < NPH; ++k) { a.ph_lo = k; a.ph_hi = k + 1; hipLaunchKernelGGL(fwd_kernel, dim3(grid), dim3(NWAVES * 64), LDS_BYTES, stream, a); }
#endif
}
```

```cpp
#include <hip/hip_runtime.h>
#include <hip/hip_cooperative_groups.h>
#include <cstdio>
#include <cstdint>
namespace cg = cooperative_groups;
#define MK_N_LAUNCHES 1
namespace pg8 {
#define PG8_LAS __attribute__((address_space(3)))
typedef unsigned short bf16_t;
typedef short bf16x8 __attribute__((ext_vector_type(8)));
typedef float f32x4 __attribute__((ext_vector_type(4)));
typedef unsigned u32x4 __attribute__((ext_vector_type(4)));
constexpr int BM = 256, BK = 64, HALF = 128, HTB = HALF * BK * 2  , STAGE_BYTES = 8 * HTB, NXCD = 8, WGM = 8;

__host__ __device__ __forceinline__ int lds_byte(int r, int c) { const int st = (r >> 4) * 2 + (c >> 5), rr = r & 15, cc = c & 31, ob = rr * 64 + cc * 2; return st * 1024 + (ob ^ (((ob >> 9) & 1) << 5)); }
__host__ __device__ __forceinline__ void stage_rc(int b, int& R, int& C) { const int st = b / 1024, sb = b % 1024, swz = sb ^ (((sb >> 9) & 1) << 5); R = (st >> 1) * 16 + swz / 64; C = (st & 1) * 32 + (swz % 64) / 2; }
__host__ __device__ __forceinline__ int perm32(int rho) { const int n = rho >> 4, i = rho & 15; return 8 * (i >> 2) + 4 * n + (i & 3); }

struct Unit { int pm, pn; };
struct Gemm { const bf16_t* A; const bf16_t* Bt; int M, N, K; };

struct StaticOrder {
    int nM, nN, nwg, G, c;
    __host__ __device__ void init(int M, int N, int G_, int c_) { nM = M / BM; nN = N / BM; nwg = nM * nN; G = G_; c = c_; }
    __host__ __device__ bool next(int i, Unit& u) const {
        const long L = (long)i * G + c; if (L >= nwg) return false;
        int wgid = (int)L; { const int q = nwg / NXCD, r = nwg % NXCD, xcd = wgid % NXCD, off = wgid / NXCD; wgid = (xcd < r ? xcd * (q + 1) : r * (q + 1) + (xcd - r) * q) + off; }
        const int nig = WGM * nN, gid = wgid / nig, fm = gid * WGM, gsz = (nM - fm) < WGM ? (nM - fm) : WGM;
        u.pm = fm + ((wgid % nig) % gsz); u.pn = (wgid % nig) / gsz; return true;
    }
    __device__ __forceinline__ void a_ready(const Unit&) const {}
    __device__ __forceinline__ void done(const Unit&) const {}
};

__device__ __forceinline__ unsigned cvt_pk_bf16(float lo, float hi) { unsigned r; asm volatile("v_cvt_pk_bf16_f32 %0, %1, %2" : "=v"(r) : "v"(lo), "v"(hi)); return r; }
typedef float f32x2 __attribute__((ext_vector_type(2)));
__device__ __forceinline__ f32x2 gelu_pk(f32x2 v) {
    const f32x2 av = __builtin_elementwise_abs(v), d = av * 0.2316418882f + 1.0f;
    f32x2 t; t.x = __builtin_amdgcn_rcpf(d.x); t.y = __builtin_amdgcn_rcpf(d.y);
    f32x2 q = t * 0.5307027145f + (-0.7265760135f); q = q * t + 0.7107068705f; q = q * t + (-0.142248368f); q = q * t + 0.127414796f; q = q * t;
    const f32x2 s = (v * v) * (-0.72134752044f);
    f32x2 e; e.x = __builtin_amdgcn_exp2f(s.x); e.y = __builtin_amdgcn_exp2f(s.y);
    const f32x2 m = v * (q * e), r = v - m;
    f32x2 o; o.x = v.x < 0.f ? m.x : r.x; o.y = v.y < 0.f ? m.y : r.y; return o;
}

template <int ACT  > struct EpiBf16 {
    static constexpr bool PERM = true, AFTER_DRAIN = false; static_assert(ACT == 0 || ACT == 1, "EpiBf16: ACT is 0 (none) or 1 (gelu_pk)");
    bf16_t* O; int ldc; const float* bias; int split_cols; size_t split_stride; float scale0;
    __device__ __forceinline__ void operator()(const f32x4 (&acc)[2][2][4][2], const Unit& u, int wr, int wc, int fr, int fq) const {
        const int row0 = u.pm * BM + wr * 64 + fr; int colt = u.pn * BM; bf16_t* base = O;
        float sc = 1.f; if (split_cols) { const int t = colt / split_cols; base += (size_t)t * split_stride; colt -= t * split_cols; if (t == 0) sc = scale0; }
        const int col0 = colt + wc * 32 + 8 * fq, bcol0 = u.pn * BM + wc * 32 + 8 * fq;
        f32x4 bv[2][2];
#pragma unroll
        for (int bj = 0; bj < 2; ++bj)
#pragma unroll
            for (int n = 0; n < 2; ++n) bv[bj][n] = bias ? *(const f32x4*)(bias + bcol0 + bj * HALF + 4 * n) : (f32x4){0.f, 0.f, 0.f, 0.f};
#pragma unroll
        for (int ai = 0; ai < 2; ++ai)
#pragma unroll
            for (int m = 0; m < 4; ++m) { bf16_t* rowp = base + (size_t)(row0 + ai * HALF + m * 16) * ldc + col0;
#pragma unroll
                for (int bj = 0; bj < 2; ++bj) { f32x4 v0 = acc[ai][bj][m][0] + bv[bj][0], v1 = acc[ai][bj][m][1] + bv[bj][1];
                    if (ACT == 1) { f32x2 a = gelu_pk((f32x2){v0[0], v0[1]}), b = gelu_pk((f32x2){v0[2], v0[3]}), c = gelu_pk((f32x2){v1[0], v1[1]}), d = gelu_pk((f32x2){v1[2], v1[3]});
                        v0 = (f32x4){a.x, a.y, b.x, b.y}; v1 = (f32x4){c.x, c.y, d.x, d.y}; }
                    v0 = v0 * sc; v1 = v1 * sc; u32x4 w; w.x = cvt_pk_bf16(v0[0], v0[1]); w.y = cvt_pk_bf16(v0[2], v0[3]); w.z = cvt_pk_bf16(v1[0], v1[1]); w.w = cvt_pk_bf16(v1[2], v1[3]);
                    *(u32x4*)(rowp + bj * HALF) = w; } }
    }
};
template <class Epi, class Sched, bool ALIGN_EPI = false, bool SP2 = false>
__device__ __forceinline__ void gemm_phase(PG8_LAS unsigned char* lds, const Gemm g, const Sched& S, const Epi& E) {
    const int tid = threadIdx.x, wid = __builtin_amdgcn_readfirstlane(tid >> 6), lane = tid & 63, wr = wid >> 2, wc = wid & 3, fr = lane & 15, fq = lane >> 4;
    const int K = g.K, nt = K / BK;
    unsigned voffA[2], voffB[2];
#pragma unroll
    for (int i = 0; i < 2; ++i) { int R, C; stage_rc(tid * 16 + i * 8192, R, C); const int Rb = Epi::PERM ? ((R & ~31) + perm32(R & 31)) : R;
        voffA[i] = (unsigned)(R * K + C) * 2u; voffB[i] = (unsigned)(Rb * K + C) * 2u; }
    const size_t kstep = (size_t)(BK * 2);
    const size_t hstep = (size_t)HALF * K * 2;
    const size_t tstep = 2 * hstep;
    const unsigned ldsw = (unsigned)wid * 1024u;
    const int aoff = lds_byte(wr * 64 + fr, fq * 8), boff = lds_byte(wc * 32 + fr, fq * 8);
#define PG8_SA(b, h) (((b) * 2 + (h)) * HTB)
#define PG8_SB(b, h) ((4 + (b) * 2 + (h)) * HTB)
#define PG8_STAGE(bufoff, gbase, voff) do { _Pragma("unroll") for (int _i = 0; _i < 2; ++_i) \
        __builtin_amdgcn_global_load_lds((const unsigned*)((const char*)(gbase) + (voff)[_i]), (PG8_LAS unsigned*)(lds + (bufoff) + ldsw + _i * 8192), 16, 0, 0); } while (0)
#define PG8_LDA(dst, b, h) do { _Pragma("unroll") for (int m = 0; m < 4; ++m) _Pragma("unroll") for (int k = 0; k < 2; ++k) dst[m][k] = *(const PG8_LAS bf16x8*)(lds + PG8_SA(b, h) + aoff + m * 2048 + k * 1024); } while (0)
#define PG8_LDB(dst, b, h) do { _Pragma("unroll") for (int n = 0; n < 2; ++n) _Pragma("unroll") for (int k = 0; k < 2; ++k) dst[n][k] = *(const PG8_LAS bf16x8*)(lds + PG8_SB(b, h) + boff + n * 2048 + k * 1024); } while (0)
#define PG8_MMA(ai, bj, At, Bt) do { __builtin_amdgcn_s_setprio(1); _Pragma("unroll") for (int m = 0; m < 4; ++m) _Pragma("unroll") for (int n = 0; n < 2; ++n) _Pragma("unroll") for (int k = 0; k < 2; ++k) \
        acc[ai][bj][m][n] = __builtin_amdgcn_mfma_f32_16x16x32_bf16(Bt[n][k], At[m][k], acc[ai][bj][m][n], 0, 0, 0); __builtin_amdgcn_s_setprio(0); } while (0)
#define PG8_WAIT_V(n) asm volatile("s_waitcnt vmcnt(" #n ")" ::: "memory")
#define PG8_WAIT_L(n) asm volatile("s_waitcnt lgkmcnt(" #n ")" ::: "memory")
#define PG8_BAR __builtin_amdgcn_s_barrier()
#define PG8_SCHED __builtin_amdgcn_sched_barrier(0)
    Unit cur, nxt; int ui = 0;
    if (!S.next(0, cur)) return;
    f32x4 acc[2][2][4][2];
#pragma unroll
    for (int a = 0; a < 2; ++a)
#pragma unroll
        for (int b = 0; b < 2; ++b)
#pragma unroll
            for (int m = 0; m < 4; ++m)
#pragma unroll
                for (int n = 0; n < 2; ++n) acc[a][b][m][n] = (f32x4){0.f, 0.f, 0.f, 0.f};
    bf16x8 At[4][2], B0[2][2], B1[2][2];
    const char* cA = (const char*)g.A + (size_t)cur.pm * tstep; const char* cB = (const char*)g.Bt + (size_t)cur.pn * tstep;
    S.a_ready(cur);
    if constexpr (SP2) {
        PG8_STAGE(PG8_SB(0, 0), cB, voffB); PG8_STAGE(PG8_SB(0, 1), cB + hstep, voffB); PG8_STAGE(PG8_SA(0, 0), cA, voffA); PG8_STAGE(PG8_SA(0, 1), cA + hstep, voffA);
        if (wr == 1) PG8_BAR;
        PG8_WAIT_V(2); PG8_BAR;
        PG8_STAGE(PG8_SB(1, 0), cB + kstep, voffB); PG8_STAGE(PG8_SA(1, 0), cA + kstep, voffA); PG8_STAGE(PG8_SB(1, 1), cB + hstep + kstep, voffB);
        PG8_WAIT_V(6); PG8_BAR;
    } else {
        PG8_STAGE(PG8_SB(0, 0), cB, voffB); PG8_STAGE(PG8_SA(0, 0), cA, voffA); PG8_STAGE(PG8_SB(0, 1), cB + hstep, voffB); PG8_STAGE(PG8_SA(0, 1), cA + hstep, voffA);
        if (wr == 1) PG8_BAR;
        PG8_WAIT_V(4); PG8_BAR;
        PG8_STAGE(PG8_SB(1, 0), cB + kstep, voffB); PG8_STAGE(PG8_SA(1, 0), cA + kstep, voffA); PG8_STAGE(PG8_SB(1, 1), cB + hstep + kstep, voffB);
        PG8_WAIT_V(6); PG8_BAR;
    }
    for (;;) {
        const bool has_next = S.next(ui + 1, nxt);
        const char* nA = has_next ? (const char*)g.A + (size_t)nxt.pm * tstep : cA; const char* nB = has_next ? (const char*)g.Bt + (size_t)nxt.pn * tstep : cB;
        for (int t = 0; t < nt; t += 2) {
            const bool last = (t == nt - 2);
            const char* a1 = cA + (size_t)(t + 1) * kstep;
            const char* a2 = last ? nA : cA + (size_t)(t + 2) * kstep; const char* b2 = last ? nB : cB + (size_t)(t + 2) * kstep;
            const char* a3 = a2 + kstep; const char* b3 = b2 + kstep;
            if (last && has_next) S.a_ready(nxt);
            if constexpr (SP2) {
            PG8_LDB(B0, 0, 0); PG8_LDB(B1, 0, 1); PG8_SCHED; PG8_LDA(At, 0, 0); PG8_STAGE(PG8_SA(1, 1), a1 + hstep, voffA);
            PG8_WAIT_V(8); PG8_WAIT_L(0); PG8_BAR; PG8_MMA(0, 0, At, B0); PG8_MMA(0, 1, At, B1); PG8_BAR; PG8_SCHED;
            PG8_LDA(At, 0, 1); PG8_STAGE(PG8_SB(0, 0), b2, voffB); PG8_STAGE(PG8_SB(0, 1), b2 + hstep, voffB); PG8_STAGE(PG8_SA(0, 0), a2, voffA);
            PG8_WAIT_V(8); PG8_WAIT_L(0); PG8_BAR; PG8_MMA(1, 0, At, B0); PG8_MMA(1, 1, At, B1); PG8_BAR; PG8_SCHED;
            PG8_LDB(B0, 1, 0); PG8_LDB(B1, 1, 1); PG8_SCHED; PG8_LDA(At, 1, 0); PG8_STAGE(PG8_SA(0, 1), a2 + hstep, voffA);
            PG8_WAIT_V(8); PG8_WAIT_L(0); PG8_BAR; PG8_MMA(0, 0, At, B0); PG8_MMA(0, 1, At, B1); PG8_BAR; PG8_SCHED;
            PG8_LDA(At, 1, 1); PG8_STAGE(PG8_SB(1, 0), b3, voffB); PG8_STAGE(PG8_SB(1, 1), b3 + hstep, voffB); PG8_STAGE(PG8_SA(1, 0), a3, voffA);
            PG8_WAIT_V(8); PG8_WAIT_L(0); PG8_BAR; PG8_MMA(1, 0, At, B0); PG8_MMA(1, 1, At, B1); PG8_BAR; PG8_SCHED;
            } else {
            PG8_LDB(B0, 0, 0); PG8_SCHED; PG8_LDA(At, 0, 0); PG8_STAGE(PG8_SA(1, 1), a1 + hstep, voffA);
            PG8_WAIT_L(8); PG8_BAR; PG8_WAIT_L(0); PG8_MMA(0, 0, At, B0); PG8_BAR; PG8_SCHED;
            PG8_LDB(B1, 0, 1); PG8_STAGE(PG8_SB(0, 0), b2, voffB);
            PG8_BAR; PG8_WAIT_L(0); PG8_MMA(0, 1, At, B1); PG8_BAR;
            PG8_LDA(At, 0, 1); PG8_STAGE(PG8_SA(0, 0), a2, voffA);
            PG8_BAR; PG8_WAIT_L(0); PG8_MMA(1, 0, At, B0); PG8_BAR; PG8_SCHED;
            PG8_STAGE(PG8_SB(0, 1), b2 + hstep, voffB);
            PG8_WAIT_V(6); PG8_BAR; PG8_MMA(1, 1, At, B1); PG8_BAR;
            PG8_LDB(B0, 1, 0); PG8_SCHED; PG8_LDA(At, 1, 0); PG8_STAGE(PG8_SA(0, 1), a2 + hstep, voffA);
            PG8_WAIT_L(8); PG8_BAR; PG8_WAIT_L(0); PG8_MMA(0, 0, At, B0); PG8_BAR; PG8_SCHED;
            PG8_LDB(B1, 1, 1); PG8_STAGE(PG8_SB(1, 0), b3, voffB);
            PG8_BAR; PG8_WAIT_L(0); PG8_MMA(0, 1, At, B1); PG8_BAR;
            PG8_LDA(At, 1, 1); PG8_STAGE(PG8_SA(1, 0), a3, voffA);
            PG8_BAR; PG8_WAIT_L(0); PG8_MMA(1, 0, At, B0); PG8_BAR; PG8_SCHED;
            PG8_STAGE(PG8_SB(1, 1), b3 + hstep, voffB);
            PG8_WAIT_V(6); PG8_BAR; PG8_MMA(1, 1, At, B1); PG8_BAR;
            }
        }
        if constexpr (ALIGN_EPI) { if (wr == 0) PG8_BAR; }
        if constexpr (!Epi::AFTER_DRAIN) { E(acc, cur, wr, wc, fr, fq); S.done(cur); }
        if (!has_next) break;
#pragma unroll
        for (int a = 0; a < 2; ++a)
#pragma unroll
            for (int b = 0; b < 2; ++b)
#pragma unroll
                for (int m = 0; m < 4; ++m)
#pragma unroll
                    for (int n = 0; n < 2; ++n) acc[a][b][m][n] = (f32x4){0.f, 0.f, 0.f, 0.f};
        cur = nxt; cA = nA; cB = nB; ++ui;
        if constexpr (ALIGN_EPI) { if (wr == 1) PG8_BAR; }
    }
    PG8_WAIT_V(0);
    if constexpr (!ALIGN_EPI) { if (wr == 0) PG8_BAR; }
    PG8_BAR;
    if constexpr (Epi::AFTER_DRAIN) { E.fused(acc, cur, wr, wc, fr, fq, lds, wid, lane); S.done(cur); }
#undef PG8_SA
#undef PG8_SB
#undef PG8_STAGE
#undef PG8_LDA
#undef PG8_LDB
#undef PG8_MMA
#undef PG8_WAIT_V
#undef PG8_WAIT_L
#undef PG8_BAR
#undef PG8_SCHED
}
}
#define GAS __attribute__((address_space(1)))
#define LAS __attribute__((address_space(3)))
typedef unsigned short bf16;
typedef unsigned v4u __attribute__((ext_vector_type(4)));
typedef float f32x4 __attribute__((ext_vector_type(4)));
typedef short bf16x8 __attribute__((ext_vector_type(8)));
typedef GAS unsigned gu32;
typedef GAS unsigned long long gu64;
#define RLX_AGENT __ATOMIC_RELAXED, __HIP_MEMORY_SCOPE_AGENT
#define LDS_WAIT() asm volatile("s_waitcnt lgkmcnt(0)" ::: "memory")
#define VM_WAIT() asm volatile("s_waitcnt vmcnt(0)" ::: "memory")
__device__ __forceinline__ unsigned long long rt() { return __builtin_amdgcn_s_memrealtime(); }
__device__ __forceinline__ unsigned f2bf(float f) { unsigned u = __builtin_bit_cast(unsigned, f); return (u + 0x7fffu + ((u >> 16) & 1u)) >> 16; }
__device__ __forceinline__ unsigned pk2(float lo, float hi) { return f2bf(lo) | (f2bf(hi) << 16); }
#define XB_TMO      128
#define XB_XCNT(j)  (256  + 64 * (j))
#define XB_XSUB(j)  (1280 + 64 * (j))
#define XB_XGEN(j)  (2304 + 64 * (j))
#define XB_TOP      3328
#define XB_TOPGEN   3392
#define XCD_BAR_WORDS 3456
#define XB_SPIN_CAP (1u << 18)

__device__ __forceinline__ unsigned xb_ld(unsigned* p)              { return __hip_atomic_load(p, __ATOMIC_RELAXED, __HIP_MEMORY_SCOPE_AGENT); }
__device__ __forceinline__ unsigned xb_add(unsigned* p, unsigned v) { return __hip_atomic_fetch_add(p, v, __ATOMIC_RELAXED, __HIP_MEMORY_SCOPE_AGENT); }
__device__ __forceinline__ unsigned xb_xcc_id() { return (unsigned)__builtin_amdgcn_s_getreg((3 << 11) | 20) & 0xFu; }
#define XB_SPIN(cond, bar) do { unsigned _sp = 0; while (cond) { __builtin_amdgcn_s_sleep(1); \
    if ((++_sp & 255u) == 0u) { if (xb_ld(&(bar)[XB_TMO])) break; if (_sp > XB_SPIN_CAP) { atomicAdd(&(bar)[XB_TMO], 1u); break; } } } } while (0)

struct XcdBarrier {
    unsigned* bar; unsigned x;
    volatile LAS unsigned* st;
};

__device__ __forceinline__ XcdBarrier xcd_barrier_post(unsigned* bar, volatile LAS unsigned* st) {
    XcdBarrier b; b.bar = bar; b.x = xb_xcc_id(); b.st = st;
    if (threadIdx.x == 0) (void)xb_add(&bar[XB_XCNT(b.x)], 1u);
    return b;
}
__device__ __forceinline__ void xcd_barrier_complete(unsigned* bar, unsigned x, unsigned& nloc, unsigned& nx) {
    const unsigned G = gridDim.x * gridDim.y * gridDim.z;
    unsigned sum, cnt, mine, sp = 0u;
    for (;;) {
        sum = 0u; cnt = 0u; mine = 0u;
#pragma unroll
        for (unsigned j = 0; j < 16; ++j) { const unsigned c = xb_ld(&bar[XB_XCNT(j)]); sum += c; cnt += (c > 0u) ? 1u : 0u; mine = (j == x) ? c : mine; }
        if (sum == G) break;
        __builtin_amdgcn_s_sleep(1);
        if ((++sp & 255u) == 0u) { if (xb_ld(&bar[XB_TMO])) break; if (sp > XB_SPIN_CAP) { atomicAdd(&bar[XB_TMO], 1u); break; } }
    }
    nloc = mine > 0u ? mine : 1u; nx = cnt > 0u ? cnt : 1u;
}

__device__ __forceinline__ void xcd_barrier(const XcdBarrier& b) {
    asm volatile("s_waitcnt vmcnt(0)" ::: "memory");
    __syncthreads();
    if (threadIdx.x == 0) {
        unsigned* bar = b.bar;
        __builtin_amdgcn_s_waitcnt(0);
        unsigned nloc = b.st[0], nx = b.st[1];
        if (nloc == 0u) { xcd_barrier_complete(bar, b.x, nloc, nx); b.st[0] = nloc; b.st[1] = nx; }
        const unsigned old = xb_add(&bar[XB_XSUB(b.x)], 1u);
        const unsigned gen = old / nloc;
        if (old + 1u == (gen + 1u) * nloc) {
            __builtin_amdgcn_fence(__ATOMIC_RELEASE, "agent");
            asm volatile("s_waitcnt vmcnt(0)" ::: "memory");
            const unsigned og = xb_add(&bar[XB_TOP], 1u);
            const unsigned tg = og / nx;
            if (og + 1u == (tg + 1u) * nx) xb_add(&bar[XB_TOPGEN], 1u);
            else XB_SPIN(xb_ld(&bar[XB_TOPGEN]) == tg, bar);
            __builtin_amdgcn_fence(__ATOMIC_ACQUIRE, "agent");
            xb_add(&bar[XB_XGEN(b.x)], 1u);
            asm volatile("s_waitcnt vmcnt(0)" ::: "memory");
        } else {
            XB_SPIN(xb_ld(&bar[XB_XGEN(b.x)]) == gen, bar);
            __builtin_amdgcn_fence(__ATOMIC_ACQUIRE, "agent");
            asm volatile("s_waitcnt vmcnt(0)" ::: "memory");
        }
    }
    __syncthreads();
}
typedef unsigned u32x4 __attribute__((ext_vector_type(4)));
__device__ __forceinline__ float wave_sum(float v) {
#pragma unroll
    for (int o = 1; o < 64; o <<= 1) v += __shfl_xor(v, o);
    return v;
}

constexpr int NWAVES = 8;
constexpr int MP = 16384, MS = 128, M = MP + MS, MPAD = 16640;
constexpr int SEQ = 8192;
constexpr int D = 1024, NPROJ = 4352, DATT = 512, DC = 512, FF = 2816;
constexpr int C_Q = 0, C_K = 512, C_V = 640, C_CB = 768, C_CC = 1280, C_CH = 1792, C_GA = 2304, C_GB = 3328;
constexpr float LN_EPS = 1e-5f;
constexpr float DN_ALPHA = 1.189207115002721f;
constexpr size_t O_YP = 0, O_YS = 16777216, O_KP = O_YS + 131072, O_VP = O_KP + 32768, O_CP = O_VP + 32768, O_FP = O_CP + 2048,
                 O_KS = O_FP + 11264, O_VS = O_KS + 2097152, O_CS = O_VS + 2097152, O_FS = O_CS + 131072, O_END = O_FS + 720896;
constexpr size_t MiB = 1u << 20;
constexpr size_t WS_CTL = 0, CTL_ZERO_BYTES = 64 * 1024;
constexpr size_t WS_WIN = 1 * MiB;
constexpr size_t WS_WAO = WS_WIN + (size_t)NPROJ * D * 2;
constexpr size_t WS_WCO = WS_WAO + (size_t)D * DATT * 2;
constexpr size_t WS_WMIX = WS_WCO + (size_t)D * DC * 2;
constexpr size_t WS_WGU = WS_WMIX + (size_t)D * D * 2;
constexpr size_t WS_WD = WS_WGU + (size_t)2 * FF * D * 2;
constexpr size_t WS_A = 32 * MiB;
constexpr size_t WS_B = WS_A + (size_t)MPAD * D * 2;
constexpr size_t WS_OATT = WS_B, WS_Z = WS_B + (size_t)MPAD * DATT * 2;
constexpr size_t WS_H2 = WS_A;
constexpr size_t WS_C = WS_B + (size_t)MPAD * D * 2;
constexpr size_t WS_P = WS_C;
constexpr size_t WS_X1 = WS_C;
constexpr size_t WS_H1 = WS_X1 + (size_t)MPAD * D * 2;
constexpr size_t WS_ACT = WS_H1;
constexpr size_t WS_HB = WS_C + (size_t)MPAD * NPROJ * 2;
constexpr size_t WS_END = WS_HB + (size_t)260 * 6 * FF * 4;
static_assert(WS_WD + (size_t)D * FF * 2 <= WS_A, "weights fit below 32 MiB");
static_assert(WS_ACT + (size_t)MPAD * FF * 2 <= WS_HB, "ACT fits in the P region");
static_assert(WS_END <= 256 * MiB, "workspace");
constexpr int CW_BAR = 1024;
constexpr int RING_BYTES = 131072, MISC_OFF = RING_BYTES, LDS_BYTES = RING_BYTES + 512;

using pg8::bf16_t; using pg8::Unit;
typedef unsigned u32x2 __attribute__((ext_vector_type(2)));
typedef float f32x16 __attribute__((ext_vector_type(16)));
constexpr int BM = 256, HALF = 128;

__device__ __forceinline__ float bf_lo(unsigned u) { return __uint_as_float(u << 16); }
__device__ __forceinline__ float bf_hi(unsigned u) { return __uint_as_float(u & 0xffff0000u); }
__device__ __forceinline__ float bf1(bf16_t h) { return __uint_as_float((unsigned)h << 16); }
__device__ __forceinline__ float sigm(float x) { return __builtin_amdgcn_rcpf(1.f + __expf(-x)); }
__device__ __forceinline__ unsigned cvtpk(float lo, float hi) { return pg8::cvt_pk_bf16(lo, hi); }
template <int CTRL> __device__ __forceinline__ float dppf(float x) { return __builtin_bit_cast(float, __builtin_amdgcn_update_dpp(0, __builtin_bit_cast(int, x), CTRL, 0xf, 0xf, false)); }
template <int CTRL> __device__ __forceinline__ f32x4 dpp4(f32x4 v) { f32x4 r; r[0] = dppf<CTRL>(v[0]); r[1] = dppf<CTRL>(v[1]); r[2] = dppf<CTRL>(v[2]); r[3] = dppf<CTRL>(v[3]); return r; }
__device__ __forceinline__ f32x4 gelu4(f32x4 v) { pg8::f32x2 a = pg8::gelu_pk((pg8::f32x2){v[0], v[1]}), b = pg8::gelu_pk((pg8::f32x2){v[2], v[3]}); return (f32x4){a.x, a.y, b.x, b.y}; }

template <int PASS> struct EpiGate {
    static constexpr bool PERM = true, AFTER_DRAIN = false;
    const bf16_t* P; bf16_t* MG;
    __device__ __forceinline__ void operator()(const f32x4 (&acc)[2][2][4][2], const Unit& u, int wr, int wc, int fr, int fq) const {
        const int row0 = u.pm * BM + wr * 64 + fr, col0 = u.pn * BM + wc * 32 + 8 * fq;
#pragma unroll
        for (int ai = 0; ai < 2; ++ai)
#pragma unroll
            for (int m = 0; m < 4; ++m) { const size_t row = (size_t)(row0 + ai * HALF + m * 16);
#pragma unroll
                for (int bj = 0; bj < 2; ++bj) { const int col = col0 + bj * HALF;
                    const u32x4 g = *(const u32x4*)(P + row * NPROJ + (PASS == 0 ? C_GA : C_GB) + col);
                    f32x4 v0 = acc[ai][bj][m][0], v1 = acc[ai][bj][m][1];
                    v0[0] *= sigm(bf_lo(g.x)); v0[1] *= sigm(bf_hi(g.x)); v0[2] *= sigm(bf_lo(g.y)); v0[3] *= sigm(bf_hi(g.y));
                    v1[0] *= sigm(bf_lo(g.z)); v1[1] *= sigm(bf_hi(g.z)); v1[2] *= sigm(bf_lo(g.w)); v1[3] *= sigm(bf_hi(g.w));
                    bf16_t* o = MG + row * D + col;
                    if (PASS == 1) { const u32x4 t = *(const u32x4*)o;
                        v0[0] += bf_lo(t.x); v0[1] += bf_hi(t.x); v0[2] += bf_lo(t.y); v0[3] += bf_hi(t.y);
                        v1[0] += bf_lo(t.z); v1[1] += bf_hi(t.z); v1[2] += bf_lo(t.w); v1[3] += bf_hi(t.w); }
                    u32x4 w; w.x = cvtpk(v0[0], v0[1]); w.y = cvtpk(v0[2], v0[3]); w.z = cvtpk(v1[0], v1[1]); w.w = cvtpk(v1[2], v1[3]);
                    *(u32x4*)o = w; } }
    }
};
struct EpiResX {
    static constexpr bool PERM = false, AFTER_DRAIN = false;
    const float* xp; const float* xs; float* H;
    __device__ __forceinline__ void operator()(const f32x4 (&acc)[2][2][4][2], const Unit& u, int wr, int wc, int fr, int fq) const {
#pragma unroll
        for (int ai = 0; ai < 2; ++ai) { const int rb = u.pm * BM + ai * HALF; if (rb >= M) continue;
            const float* xb = rb < MP ? xp + (size_t)rb * D : xs + (size_t)(rb - MP) * D; float* hb = H + (size_t)rb * D;
#pragma unroll
            for (int m = 0; m < 4; ++m) { const size_t ro = (size_t)(wr * 64 + m * 16 + fr) * D;
#pragma unroll
                for (int bj = 0; bj < 2; ++bj)
#pragma unroll
                    for (int n = 0; n < 2; ++n) { const int col = u.pn * BM + bj * HALF + wc * 32 + n * 16 + 4 * fq;
                        const f32x4 xv = *(const f32x4*)(xb + ro + col); *(f32x4*)(hb + ro + col) = xv * DN_ALPHA + acc[ai][bj][m][n]; } } }
    }
};
struct EpiResB {
    static constexpr bool PERM = false, AFTER_DRAIN = false;
    const bf16_t* X1; float* H;
    __device__ __forceinline__ void operator()(const f32x4 (&acc)[2][2][4][2], const Unit& u, int wr, int wc, int fr, int fq) const {
#pragma unroll
        for (int ai = 0; ai < 2; ++ai) { const int rb = u.pm * BM + ai * HALF; if (rb >= M) continue;
#pragma unroll
            for (int m = 0; m < 4; ++m) { const size_t ro = (size_t)(rb + wr * 64 + m * 16 + fr) * D;
#pragma unroll
                for (int bj = 0; bj < 2; ++bj)
#pragma unroll
                    for (int n = 0; n < 2; ++n) { const int col = u.pn * BM + bj * HALF + wc * 32 + n * 16 + 4 * fq;
                        const u32x2 xv = *(const u32x2*)(X1 + ro + col); const f32x4 x4 = {bf_lo(xv.x), bf_hi(xv.x), bf_lo(xv.y), bf_hi(xv.y)};
                        *(f32x4*)(H + ro + col) = x4 * DN_ALPHA + acc[ai][bj][m][n]; } } }
    }
};
struct EpiGU {
    static constexpr bool PERM = true, AFTER_DRAIN = false;
    bf16_t* ACT; float* HB; const float* cw; const float* stf; float* out;
    __device__ __forceinline__ void operator()(const f32x4 (&acc)[2][2][4][2], const Unit& u, int wr, int wc, int fr_, int fq_) const {
        int fr = fr_, fq = fq_; asm volatile("" : "+v"(fr), "+v"(fq));
#pragma unroll
        for (int n = 0; n < 2; ++n) {
            const int c0 = u.pn * HALF + wc * 32 + 8 * fq + 4 * n;
            const f32x4 w0 = *(const f32x4*)(cw + c0), w1 = *(const f32x4*)(cw + FF + c0), w2 = *(const f32x4*)(cw + 2 * FF + c0);
            if (u.pm < MP / BM) {
#pragma unroll
                for (int ai = 0; ai < 2; ++ai) { const int rbase = u.pm * BM + ai * HALF + wr * 64; const int G = rbase >> 6;
                    float* hb = HB + (size_t)G * 6 * FF + c0;
                    const bool lastg = ((rbase + 64) & (SEQ - 1)) == 0;
#pragma unroll
                    for (int m = 0; m < 4; ++m) { const size_t row = (size_t)(rbase + m * 16 + fr);
                        const f32x4 cur = acc[ai][0][m][n], upv = acc[ai][1][m][n];
                        f32x4 g1 = dpp4<0x121>(cur), g2 = dpp4<0x122>(cur);
                        if (m > 0) { const f32x4 p1 = dpp4<0x121>(acc[ai][0][m - 1][n]), p2 = dpp4<0x122>(acc[ai][0][m - 1][n]); if (fr < 1) g1 = p1; if (fr < 2) g2 = p2; }
                        const f32x4 a = gelu4(w0 * g2 + w1 * g1 + w2 * cur) * upv;
                        u32x2 w; w.x = cvtpk(a[0], a[1]); w.y = cvtpk(a[2], a[3]);
                        if (m == 0 && fr < 2) { *(f32x4*)(hb + (size_t)fr * FF) = cur; *(f32x4*)(hb + (size_t)(4 + fr) * FF) = upv; }
                        if (m == 3 && fr >= 14) { *(f32x4*)(hb + (size_t)(2 + fr - 14) * FF) = cur;
                            if (lastg) *(f32x4*)(out + O_FP + (size_t)((rbase >> 13) * 2 + fr - 14) * FF + c0) = cur; }
                        if (!(m == 0 && fr < 2)) *(u32x2*)(ACT + row * FF + c0) = w; } }
            } else {
#pragma unroll
                for (int m = 0; m < 4; ++m) { const int ns = wr * 64 + m * 16 + fr;
                    const f32x4 cur = acc[0][0][m][n], upv = acc[0][1][m][n];
                    const f32x4 g2 = *(const f32x4*)(stf + (size_t)(ns * 2 + 0) * FF + c0), g1 = *(const f32x4*)(stf + (size_t)(ns * 2 + 1) * FF + c0);
                    const f32x4 a = gelu4(w0 * g2 + w1 * g1 + w2 * cur) * upv;
                    u32x2 w; w.x = cvtpk(a[0], a[1]); w.y = cvtpk(a[2], a[3]);
                    *(f32x4*)(out + O_FS + (size_t)(ns * 2 + 0) * FF + c0) = g1; *(f32x4*)(out + O_FS + (size_t)(ns * 2 + 1) * FF + c0) = cur;
                    *(u32x2*)(ACT + (size_t)(MP + ns) * FF + c0) = w; }
            }
            __builtin_amdgcn_sched_barrier(0);
        }
    }
};

__device__ __forceinline__ void p0_item(const float* W, int K, int N, bf16* WT, int mode, LAS float* scr, int item, int lane) {
    const int nblk = N / 32, kb = item / nblk, nb = item % nblk, k0 = 64 * kb, n0 = 32 * nb;
    const int drow = mode == 0 ? n0 : 256 * (n0 >> 7) + (n0 & 127) + (mode == 2 ? 128 : 0);
#pragma unroll 8
    for (int i = 0; i < 32; ++i) { const int kk = 2 * i + (lane >> 5); scr[kk * 33 + (lane & 31)] = W[(size_t)(k0 + kk) * N + n0 + (lane & 31)]; }
    LDS_WAIT(); asm volatile("" ::: "memory");
    const int c = lane & 7;
#pragma unroll
    for (int j = 0; j < 4; ++j) { const int n = (lane >> 3) + 8 * j; const LAS float* s = scr + (8 * c) * 33 + n;
        v4u o; o.x = pk2(s[0 * 33], s[1 * 33]); o.y = pk2(s[2 * 33], s[3 * 33]); o.z = pk2(s[4 * 33], s[5 * 33]); o.w = pk2(s[6 * 33], s[7 * 33]);
        *(GAS v4u*)(WT + (size_t)(drow + n) * K + k0 + 8 * c) = o; }
    LDS_WAIT(); asm volatile("" ::: "memory");
}
struct In { const float *xp, *xs, *ck, *cv, *stc, *stf, *w_in, *conv_w, *sinks, *w_ao, *w_co, *w_mix, *ln1g, *ln1b, *w_gate, *w_up, *fcw, *w_down, *ln2g, *ln2b; };

__device__ __forceinline__ void p0_prologue(const In& I, unsigned char* ws, LAS unsigned char* lds, int gw, int NGW, int wave, int lane) {
    LAS float* scr = (LAS float*)(lds + wave * 16384);
    constexpr int I_IN = (D / 64) * (NPROJ / 32), I_AO = (DATT / 64) * (D / 32), I_MIX = (D / 64) * (D / 32), I_G = (D / 64) * (FF / 32), I_D = (FF / 64) * (D / 32);
    constexpr int NITEMS = I_IN + 2 * I_AO + I_MIX + 2 * I_G + I_D;
    for (int it = gw; it < NITEMS; it += NGW) {
        int r = it;
        if (r < I_IN) { p0_item(I.w_in, D, NPROJ, (bf16*)(ws + WS_WIN), 0, scr, r, lane); continue; } r -= I_IN;
        if (r < I_AO) { p0_item(I.w_ao, DATT, D, (bf16*)(ws + WS_WAO), 0, scr, r, lane); continue; } r -= I_AO;
        if (r < I_AO) { p0_item(I.w_co, DC, D, (bf16*)(ws + WS_WCO), 0, scr, r, lane); continue; } r -= I_AO;
        if (r < I_MIX) { p0_item(I.w_mix, D, D, (bf16*)(ws + WS_WMIX), 0, scr, r, lane); continue; } r -= I_MIX;
        if (r < I_G) { p0_item(I.w_gate, D, FF, (bf16*)(ws + WS_WGU), 1, scr, r, lane); continue; } r -= I_G;
        if (r < I_G) { p0_item(I.w_up, D, FF, (bf16*)(ws + WS_WGU), 2, scr, r, lane); continue; } r -= I_G;
        p0_item(I.w_down, FF, D, (bf16*)(ws + WS_WD), 0, scr, r, lane);
    }
    bf16* XB = (bf16*)(ws + WS_A);
    for (int m = gw; m < MPAD; m += NGW) {
        GAS unsigned long long* o8 = (GAS unsigned long long*)(XB + (size_t)m * D) + lane;
        if (m < M) { const float* xr = m < MP ? I.xp + (size_t)m * D : I.xs + (size_t)(m - MP) * D; const GAS f32x4* x4 = (const GAS f32x4*)xr + lane;
#pragma unroll
            for (int j = 0; j < 4; ++j) { const f32x4 v = x4[64 * j]; o8[64 * j] = (unsigned long long)pk2(v.x, v.y) | ((unsigned long long)pk2(v.z, v.w) << 32); }
        } else {
#pragma unroll
            for (int j = 0; j < 4; ++j) o8[64 * j] = 0ull;
        }
    }
}

typedef short s16x8 __attribute__((ext_vector_type(8)));
__device__ __forceinline__ void attn_prompt_unit(LAS unsigned char* lds, const bf16_t* P, bf16_t* OA, const float* sinks, int b, int i, int kvh, int tid) {
    LAS bf16_t* Ks = (LAS bf16_t*)lds;
    LAS bf16_t* VT = (LAS bf16_t*)(lds + 36864);
    const int lane = tid & 63, w = tid >> 6, l31 = lane & 31, hi = lane >> 5;
    const long rowbase = (long)b * SEQ + (long)(i - 1) * 128;
#pragma unroll
    for (int it = 0; it < 4; ++it) { const int ch = tid + it * 512, j = ch >> 3, c = ch & 7;
        const int jj = (i == 0 && j < 128) ? j + 128 : j;
        const bf16_t* src = P + (size_t)(rowbase + jj) * NPROJ + C_K + kvh * 64 + c * 8;
        const u32x4 kv = *(const u32x4*)src; const u32x4 vv = *(const u32x4*)(src + (C_V - C_K));
        *(LAS u32x4*)(Ks + j * 72 + c * 8) = kv;
        LAS bf16_t* vt = VT + (c * 8) * 260 + j;
        vt[0 * 260] = (bf16_t)(vv.x & 0xffffu); vt[1 * 260] = (bf16_t)(vv.x >> 16); vt[2 * 260] = (bf16_t)(vv.y & 0xffffu); vt[3 * 260] = (bf16_t)(vv.y >> 16);
        vt[4 * 260] = (bf16_t)(vv.z & 0xffffu); vt[5 * 260] = (bf16_t)(vv.z >> 16); vt[6 * 260] = (bf16_t)(vv.w & 0xffffu); vt[7 * 260] = (bf16_t)(vv.w >> 16); }
    __syncthreads();
    const int g = w >> 1, h = kvh * 4 + g;
    const float slope = exp2f(-(float)(h + 1)), sink = sinks[h];
#pragma unroll 1
    for (int t = 0; t < 2; ++t) {
        const int a0 = 64 * (w & 1) + 32 * t;
        const size_t qrow = (size_t)b * SEQ + (size_t)i * 128 + a0 + l31;
        s16x8 Bq[4];
#pragma unroll
        for (int s = 0; s < 4; ++s) Bq[s] = *(const s16x8*)(P + qrow * NPROJ + C_Q + h * 64 + 16 * s + 8 * hi);
        f32x16 S[5];
#pragma unroll
        for (int jt = 0; jt < 5; ++jt) {
#pragma unroll
            for (int r = 0; r < 16; ++r) S[jt][r] = 0.f;
#pragma unroll
            for (int s = 0; s < 4; ++s) { const s16x8 A = *(const LAS s16x8*)(Ks + (a0 + 32 * jt + l31) * 72 + 16 * s + 8 * hi);
                S[jt] = __builtin_amdgcn_mfma_f32_32x32x16_bf16(A, Bq[s], S[jt], 0, 0, 0); }
            __builtin_amdgcn_sched_barrier(0); }
        float mx = -1e30f;
        float basef = (float)(128 + l31 - 4 * hi), ubf = (i > 0) ? 128.f : fminf(128.f, (float)(l31 + a0));
        asm volatile("" : "+v"(basef), "+v"(ubf));
#pragma unroll
        for (int jt = 0; jt < 5; ++jt) {
#pragma unroll
            for (int r = 0; r < 16; ++r) { const float dist = basef - (float)(32 * jt + (r & 3) + 8 * (r >> 2));
                const bool valid = (dist >= 0.f) && (dist <= ubf);
                const float sv = valid ? S[jt][r] * 0.125f - slope * dist : -1e30f; S[jt][r] = sv; mx = fmaxf(mx, sv); }
            __builtin_amdgcn_sched_barrier(0); }
        mx = fmaxf(mx, __shfl_xor(mx, 32)); mx = fmaxf(mx, sink);
        float sum = 0.f;
#pragma unroll
        for (int jt = 0; jt < 5; ++jt) {
#pragma unroll
            for (int r = 0; r < 16; ++r) { const float p = __expf(S[jt][r] - mx); S[jt][r] = p; sum += p; }
            __builtin_amdgcn_sched_barrier(0); }
        sum += __shfl_xor(sum, 32);
        const float inv = 1.f / (sum + __expf(sink - mx));
        f32x16 O[2];
#pragma unroll
        for (int dt = 0; dt < 2; ++dt)
#pragma unroll
            for (int r = 0; r < 16; ++r) O[dt][r] = 0.f;
#pragma unroll
        for (int jt = 0; jt < 5; ++jt)
#pragma unroll
            for (int s2 = 0; s2 < 2; ++s2) {
                u32x4 pb; pb.x = cvtpk(S[jt][8 * s2 + 0], S[jt][8 * s2 + 1]); pb.y = cvtpk(S[jt][8 * s2 + 2], S[jt][8 * s2 + 3]); pb.z = cvtpk(S[jt][8 * s2 + 4], S[jt][8 * s2 + 5]); pb.w = cvtpk(S[jt][8 * s2 + 6], S[jt][8 * s2 + 7]);
                const s16x8 Bp = __builtin_bit_cast(s16x8, pb);
                const int kb = a0 + 32 * jt + 16 * s2 + 4 * hi;
#pragma unroll
                for (int dt = 0; dt < 2; ++dt) { const LAS bf16_t* vp = VT + (32 * dt + l31) * 260 + kb;
                    u32x4 av; const u32x2 lo = *(const LAS u32x2*)vp, hi2 = *(const LAS u32x2*)(vp + 8); av.x = lo.x; av.y = lo.y; av.z = hi2.x; av.w = hi2.y;
                    O[dt] = __builtin_amdgcn_mfma_f32_32x32x16_bf16(__builtin_bit_cast(s16x8, av), Bp, O[dt], 0, 0, 0); }
                __builtin_amdgcn_sched_barrier(0); }
        bf16_t* orow = OA + qrow * DATT + h * 64;
#pragma unroll
        for (int dt = 0; dt < 2; ++dt)
#pragma unroll
            for (int gq = 0; gq < 4; ++gq) { u32x2 o; o.x = cvtpk(O[dt][4 * gq + 0] * inv, O[dt][4 * gq + 1] * inv); o.y = cvtpk(O[dt][4 * gq + 2] * inv, O[dt][4 * gq + 3] * inv);
                *(u32x2*)(orow + 32 * dt + 8 * gq + 4 * hi) = o; }
    }
    __syncthreads();
}
__device__ __forceinline__ void attn_sample_unit(LAS unsigned char* lds, const bf16_t* P, bf16_t* OA, const float* ck, const float* cv, const float* sinks, float* out, int n, int kvh, int tid) {
    LAS float* Ks = (LAS float*)lds;
    LAS float* Vs = (LAS float*)(lds + 33792);
    LAS float* qs = (LAS float*)(lds + 67584);
    LAS float* sc = (LAS float*)(lds + 68608);
    const int lane = tid & 63, w = tid >> 6;
#pragma unroll
    for (int it = 0; it < 4; ++it) { const int idx = tid + it * 512, s = idx >> 4, c4 = (idx & 15) * 4;
        const size_t off = ((size_t)(n * 128 + s) * 2 + kvh) * 64 + c4;
        const f32x4 kk = *(const f32x4*)(ck + off), vv = *(const f32x4*)(cv + off);
        Ks[s * 65 + c4 + 0] = kk.x; Ks[s * 65 + c4 + 1] = kk.y; Ks[s * 65 + c4 + 2] = kk.z; Ks[s * 65 + c4 + 3] = kk.w;
        Vs[s * 65 + c4 + 0] = vv.x; Vs[s * 65 + c4 + 1] = vv.y; Vs[s * 65 + c4 + 2] = vv.z; Vs[s * 65 + c4 + 3] = vv.w;
        if (s >= 1) { *(f32x4*)(out + O_KS + off - 128) = kk; *(f32x4*)(out + O_VS + off - 128) = vv; } }
    const bf16_t* prow = P + (size_t)(MP + n) * NPROJ;
    if (tid < 64) { const float kn = bf1(prow[C_K + kvh * 64 + tid]), vn = bf1(prow[C_V + kvh * 64 + tid]);
        Ks[128 * 65 + tid] = kn; Vs[128 * 65 + tid] = vn;
        const size_t off = ((size_t)(n * 128 + 127) * 2 + kvh) * 64 + tid; out[O_KS + off] = kn; out[O_VS + off] = vn; }
    if (tid < 256) qs[tid] = bf1(prow[C_Q + kvh * 256 + tid]);
    __syncthreads();
    for (int idx = tid; idx < 4 * 129; idx += 512) { const int g = idx / 129, s = idx - g * 129; float dot = 0.f;
#pragma unroll 8
        for (int d = 0; d < 64; ++d) dot += qs[g * 64 + d] * Ks[s * 65 + d];
        sc[g * 132 + s] = dot * 0.125f - exp2f(-(float)(kvh * 4 + g + 1)) * (float)(128 - s); }
    __syncthreads();
    if (w < 4) { const float sink = sinks[kvh * 4 + w];
        const float s0 = sc[w * 132 + lane], s1 = sc[w * 132 + 64 + lane], s2 = lane == 0 ? sc[w * 132 + 128] : -1e30f;
        float mx = fmaxf(fmaxf(s0, s1), s2);
#pragma unroll
        for (int o = 1; o < 64; o <<= 1) mx = fmaxf(mx, __shfl_xor(mx, o));
        mx = fmaxf(mx, sink);
        const float p0 = __expf(s0 - mx), p1 = __expf(s1 - mx), p2 = lane == 0 ? __expf(s2 - mx) : 0.f;
        float sum = p0 + p1 + p2;
#pragma unroll
        for (int o = 1; o < 64; o <<= 1) sum += __shfl_xor(sum, o);
        const float inv = 1.f / (sum + __expf(sink - mx));
        sc[w * 132 + lane] = p0 * inv; sc[w * 132 + 64 + lane] = p1 * inv; if (lane == 0) sc[w * 132 + 128] = p2 * inv; }
    __syncthreads();
    if (tid < 256) { const int g = tid >> 6, d = tid & 63; float o = 0.f;
#pragma unroll 4
        for (int s = 0; s < 129; ++s) o += sc[g * 132 + s] * Vs[s * 65 + d];
        OA[(size_t)(MP + n) * DATT + (kvh * 4 + g) * 64 + d] = (bf16_t)(cvtpk(o, 0.f) & 0xffffu); }
    __syncthreads();
}
__device__ __forceinline__ void unpack8(const u32x4 v, float (&f)[8]) { f[0] = bf_lo(v.x); f[1] = bf_hi(v.x); f[2] = bf_lo(v.y); f[3] = bf_hi(v.y); f[4] = bf_lo(v.z); f[5] = bf_hi(v.z); f[6] = bf_lo(v.w); f[7] = bf_hi(v.w); }
__device__ __forceinline__ void conv_phase(const bf16_t* P, bf16_t* Z, const float* cw, const float* stc, float* out, int gtid, int NT) {
    for (int item = gtid; item < M * 64; item += NT) { const int r = item >> 6, c = (item & 63) * 8;
        const bf16_t* pr = P + (size_t)r * NPROJ;
        float cb[8], u0[8], u1[8], u2[8], t0[8], t1[8];
        unpack8(*(const u32x4*)(pr + C_CB + c), cb); unpack8(*(const u32x4*)(pr + C_CC + c), t0); unpack8(*(const u32x4*)(pr + C_CH + c), t1);
#pragma unroll
        for (int e = 0; e < 8; ++e) u0[e] = t0[e] * t1[e];
        if (r < MP) { const int t = r & (SEQ - 1);
            if (t >= 1) { unpack8(*(const u32x4*)(pr - NPROJ + C_CC + c), t0); unpack8(*(const u32x4*)(pr - NPROJ + C_CH + c), t1);
#pragma unroll
                for (int e = 0; e < 8; ++e) u1[e] = t0[e] * t1[e]; }
            else {
#pragma unroll
                for (int e = 0; e < 8; ++e) u1[e] = 0.f; }
            if (t >= 2) { unpack8(*(const u32x4*)(pr - 2 * NPROJ + C_CC + c), t0); unpack8(*(const u32x4*)(pr - 2 * NPROJ + C_CH + c), t1);
#pragma unroll
                for (int e = 0; e < 8; ++e) u2[e] = t0[e] * t1[e]; }
            else {
#pragma unroll
                for (int e = 0; e < 8; ++e) u2[e] = 0.f; }
            if (t >= SEQ - 2) { float* o = out + O_CP + (size_t)((r >> 13) * 2 + (t - (SEQ - 2))) * DC + c;
                *(f32x4*)o = (f32x4){u0[0], u0[1], u0[2], u0[3]}; *(f32x4*)(o + 4) = (f32x4){u0[4], u0[5], u0[6], u0[7]}; }
        } else { const int ns = r - MP; const float* s0 = stc + (size_t)(ns * 2) * DC + c; const float* s1 = s0 + DC;
            const f32x4 a0 = *(const f32x4*)s0, a1 = *(const f32x4*)(s0 + 4), b0 = *(const f32x4*)s1, b1 = *(const f32x4*)(s1 + 4);
            u2[0] = a0.x; u2[1] = a0.y; u2[2] = a0.z; u2[3] = a0.w; u2[4] = a1.x; u2[5] = a1.y; u2[6] = a1.z; u2[7] = a1.w;
            u1[0] = b0.x; u1[1] = b0.y; u1[2] = b0.z; u1[3] = b0.w; u1[4] = b1.x; u1[5] = b1.y; u1[6] = b1.z; u1[7] = b1.w;
            float* o = out + O_CS + (size_t)(ns * 2) * DC + c;
            *(f32x4*)o = b0; *(f32x4*)(o + 4) = b1; *(f32x4*)(o + DC) = (f32x4){u0[0], u0[1], u0[2], u0[3]}; *(f32x4*)(o + DC + 4) = (f32x4){u0[4], u0[5], u0[6], u0[7]}; }
        float z[8];
#pragma unroll
        for (int e = 0; e < 8; ++e) z[e] = cb[e] * (cw[c + e] * u2[e] + cw[DC + c + e] * u1[e] + cw[2 * DC + c + e] * u0[e]);
        u32x4 w; w.x = cvtpk(z[0], z[1]); w.y = cvtpk(z[2], z[3]); w.z = cvtpk(z[4], z[5]); w.w = cvtpk(z[6], z[7]);
        *(u32x4*)(Z + (size_t)r * DC + c) = w; }
    for (int item = gtid; item < 2 * 128 * 32; item += NT) { const int b = item >> 12, i = (item >> 5) & 127, c8 = (item & 31) * 8;
        float f[8]; unpack8(*(const u32x4*)(P + (size_t)(b * SEQ + SEQ - 128 + i) * NPROJ + C_K + c8), f);
        float* o = (c8 < 128 ? out + O_KP + (size_t)(b * 128 + i) * 128 + c8 : out + O_VP + (size_t)(b * 128 + i) * 128 + (c8 - 128));
        *(f32x4*)o = (f32x4){f[0], f[1], f[2], f[3]}; *(f32x4*)(o + 4) = (f32x4){f[4], f[5], f[6], f[7]}; }
}

template <bool OUT_BF16> __device__ __forceinline__ void ln_phase(const float* H, const float* gam, const float* bet, bf16_t* Xo, float* out, int gw, int NGW, int lane) {
    f32x4 g4[4], b4[4];
#pragma unroll
    for (int j = 0; j < 4; ++j) { g4[j] = ((const f32x4*)gam)[lane + 64 * j]; b4[j] = ((const f32x4*)bet)[lane + 64 * j]; }
    for (int m = gw; m < M; m += NGW) {
        const f32x4* xr = (const f32x4*)(H + (size_t)m * D) + lane;
        f32x4 v[4]; float s = 0.f;
#pragma unroll
        for (int j = 0; j < 4; ++j) { v[j] = xr[64 * j]; s += (v[j].x + v[j].y) + (v[j].z + v[j].w); }
        const float mean = wave_sum(s) * (1.f / D); float s2 = 0.f;
#pragma unroll
        for (int j = 0; j < 4; ++j) { v[j] = v[j] - mean; s2 += (v[j].x * v[j].x + v[j].y * v[j].y) + (v[j].z * v[j].z + v[j].w * v[j].w); }
        const float rstd = 1.f / sqrtf(wave_sum(s2) * (1.f / D) + LN_EPS);
        if (OUT_BF16) { unsigned long long* o8 = (unsigned long long*)(Xo + (size_t)m * D) + lane;
#pragma unroll
            for (int j = 0; j < 4; ++j) { const f32x4 y = v[j] * rstd * g4[j] + b4[j]; o8[64 * j] = (unsigned long long)cvtpk(y.x, y.y) | ((unsigned long long)cvtpk(y.z, y.w) << 32); }
        } else { f32x4* o = (f32x4*)(m < MP ? out + O_YP + (size_t)m * D : out + O_YS + (size_t)(m - MP) * D) + lane;
#pragma unroll
            for (int j = 0; j < 4; ++j) o[64 * j] = v[j] * rstd * g4[j] + b4[j]; }
    }
}
__device__ __forceinline__ void halo_phase(const float* HB, const float* cw, bf16_t* ACT, int gtid, int NT) {
    constexpr int C4 = FF / 4;
    for (int item = gtid; item < (MP / 64) * 2 * C4; item += NT) { const int c4 = (item % C4) * 4, rr = item / C4, G = rr >> 1, j = rr & 1;
        const float* hb = HB + (size_t)G * 6 * FF + c4; const bool first = (G & 127) == 0;
        const f32x4 z = {0.f, 0.f, 0.f, 0.f};
        const f32x4 g0 = *(const f32x4*)hb, pl1 = first ? z : *(const f32x4*)(hb - 6 * FF + 3 * FF);
        f32x4 cur, gm1, gm2, upv;
        if (j == 0) { cur = g0; gm1 = pl1; gm2 = first ? z : *(const f32x4*)(hb - 6 * FF + 2 * FF); upv = *(const f32x4*)(hb + 4 * FF); }
        else { cur = *(const f32x4*)(hb + FF); gm1 = g0; gm2 = pl1; upv = *(const f32x4*)(hb + 5 * FF); }
        const f32x4 w0 = *(const f32x4*)(cw + c4), w1 = *(const f32x4*)(cw + FF + c4), w2 = *(const f32x4*)(cw + 2 * FF + c4);
        const f32x4 a = gelu4(w0 * gm2 + w1 * gm1 + w2 * cur) * upv;
        u32x2 w; w.x = cvtpk(a[0], a[1]); w.y = cvtpk(a[2], a[3]);
        *(u32x2*)(ACT + (size_t)(64 * G + j) * FF + c4) = w; }
}

#ifndef MK_N_LAUNCHES
#define MK_N_LAUNCHES 1
#endif
constexpr int NPH = 10;
struct Args { const float* in[20]; float* out; unsigned char* ws; int ph_lo, ph_hi, never, pad; };
__global__ void __launch_bounds__(NWAVES * 64, 2) fwd_kernel(Args args) {
    extern __shared__ __attribute__((aligned(16))) unsigned char lds_raw[];
    LAS unsigned char* lds = (LAS unsigned char*)lds_raw;
    volatile LAS unsigned* MISC = (volatile LAS unsigned*)(lds + MISC_OFF);
    const int tid = threadIdx.x, lane = tid & 63, wave = __builtin_amdgcn_readfirstlane(tid >> 6);
    const int G = gridDim.x, bx = blockIdx.x;
    const int gw = bx * NWAVES + wave, NGW = G * NWAVES, gtid = bx * (NWAVES * 64) + tid, NT = G * NWAVES * 64;
    unsigned char* ws = args.ws; float* out = args.out;
    In I; I.xp = args.in[0]; I.xs = args.in[1]; I.ck = args.in[2]; I.cv = args.in[3]; I.stc = args.in[4]; I.stf = args.in[5]; I.w_in = args.in[6]; I.conv_w = args.in[7]; I.sinks = args.in[8];
    I.w_ao = args.in[9]; I.w_co = args.in[10]; I.w_mix = args.in[11]; I.ln1g = args.in[12]; I.ln1b = args.in[13]; I.w_gate = args.in[14]; I.w_up = args.in[15]; I.fcw = args.in[16]; I.w_down = args.in[17];
    I.ln2g = args.in[18]; I.ln2b = args.in[19];
    if (args.never) cg::this_grid().sync();
    for (int u = tid; u < (LDS_BYTES - MISC_OFF) / 4; u += NWAVES * 64) ((LAS unsigned*)(lds + MISC_OFF))[u] = 0u;
    __syncthreads();
    const int lo = args.ph_lo, hi = args.ph_hi;
    const bool multi = (hi - lo) > 1;
    XcdBarrier bar; bar.bar = (unsigned*)(ws + WS_CTL) + CW_BAR; bar.x = 0; bar.st = nullptr;
    if (multi) bar = xcd_barrier_post((unsigned*)(ws + WS_CTL) + CW_BAR, MISC + 8);
#ifndef PH_MASK
#define PH_MASK 0x3ff
#endif
#define IN(k) (((PH_MASK >> (k)) & 1) && lo <= (k) && (k) < hi)
#define SEAM(k) do { if (IN(k) && IN((k) + 1)) xcd_barrier(bar); } while (0)
    bf16_t* const XB = (bf16_t*)(ws + WS_A); bf16_t* const MG = (bf16_t*)(ws + WS_A); bf16_t* const OATT = (bf16_t*)(ws + WS_OATT); bf16_t* const Z = (bf16_t*)(ws + WS_Z);
    bf16_t* const P = (bf16_t*)(ws + WS_P); bf16_t* const X1 = (bf16_t*)(ws + WS_X1); float* const H1 = (float*)(ws + WS_H1); bf16_t* const ACT = (bf16_t*)(ws + WS_ACT);
    float* const H2 = (float*)(ws + WS_H2); float* const HB = (float*)(ws + WS_HB);

    if (IN(0)) { p0_prologue(I, ws, lds, gw, NGW, wave, lane); }
    SEAM(0);
    if (IN(1)) {
        pg8::Gemm g{XB, (const bf16_t*)(ws + WS_WIN), MPAD, NPROJ, D}; pg8::StaticOrder S; S.init(MPAD, NPROJ, G, bx);
        pg8::EpiBf16<0> E{P, NPROJ, nullptr, 0, 0, 1.f};
        pg8::gemm_phase<pg8::EpiBf16<0>, pg8::StaticOrder, true, true>(lds, g, S, E);
    }
    SEAM(1);
    if (IN(2)) {
        for (int un = bx; un < 512; un += G) {
#ifndef NO_AP
            if (un < 256) attn_prompt_unit(lds, P, OATT, I.sinks, un >> 7, (un >> 1) & 63, un & 1, tid);
#endif
#ifndef NO_AS
            if (un >= 256) attn_sample_unit(lds, P, OATT, I.ck, I.cv, I.sinks, out, (un - 256) >> 1, un & 1, tid);
#endif
        }
#ifndef NO_CV
        conv_phase(P, Z, I.conv_w, I.stc, out, gtid, NT);
#endif
    }
    SEAM(2);
    if (IN(3)) {
        pg8::StaticOrder S; S.init(MPAD, D, G, bx);
        { pg8::Gemm g{OATT, (const bf16_t*)(ws + WS_WAO), MPAD, D, DATT}; EpiGate<0> E{P, MG}; pg8::gemm_phase<EpiGate<0>, pg8::StaticOrder, true, true>(lds, g, S, E); }
        { pg8::Gemm g{Z, (const bf16_t*)(ws + WS_WCO), MPAD, D, DC}; EpiGate<1> E{P, MG}; pg8::gemm_phase<EpiGate<1>, pg8::StaticOrder, true, true>(lds, g, S, E); }
    }
    SEAM(3);
    if (IN(4)) {
        pg8::Gemm g{MG, (const bf16_t*)(ws + WS_WMIX), MPAD, D, D}; pg8::StaticOrder S; S.init(MPAD, D, G, bx);
        EpiResX E{I.xp, I.xs, H1}; pg8::gemm_phase<EpiResX, pg8::StaticOrder, true, true>(lds, g, S, E);
    }
    SEAM(4);
    if (IN(5)) ln_phase<true>(H1, I.ln1g, I.ln1b, X1, nullptr, gw, NGW, lane);
    SEAM(5);
    if (IN(6)) {
        pg8::Gemm g{X1, (const bf16_t*)(ws + WS_WGU), MPAD, 2 * FF, D}; pg8::StaticOrder S; S.init(MPAD, 2 * FF, G, bx);
        EpiGU E{ACT, HB, I.fcw, I.stf, out}; pg8::gemm_phase<EpiGU, pg8::StaticOrder, true, true>(lds, g, S, E);
    }
    SEAM(6);
    if (IN(7)) halo_phase(HB, I.fcw, ACT, gtid, NT);
    SEAM(7);
    if (IN(8)) {
        pg8::Gemm g{ACT, (const bf16_t*)(ws + WS_WD), MPAD, D, FF}; pg8::StaticOrder S; S.init(MPAD, D, G, bx);
        EpiResB E{X1, H2}; pg8::gemm_phase<EpiResB, pg8::StaticOrder, true, true>(lds, g, S, E);
    }
    SEAM(8);
    if (IN(9)) ln_phase<false>(H2, I.ln2g, I.ln2b, nullptr, out, gw, NGW, lane);
#undef IN
#undef SEAM
}

extern "C" void kernel_launch(void* const* d_in, const int* in_sizes, int n_in, void* d_out, int out_size, void* d_ws, size_t ws_size, hipStream_t stream) {
    static int grid = 0;
    if (grid == 0) {
        if (n_in != 20 || (size_t)out_size != O_END || ws_size < WS_END) { fprintf(stderr, "kernel_launch: unexpected shapes: n_in %d out %d ws %zu (need %zu)\n", n_in, out_size, ws_size, (size_t)WS_END); grid = -1; return; }
        int dev = 0, cus = 0, per_cu = 0;
        if (hipGetDevice(&dev) != hipSuccess || hipDeviceGetAttribute(&cus, hipDeviceAttributeMultiprocessorCount, dev) != hipSuccess) { grid = -1; return; }
        if (hipFuncSetAttribute((const void*)fwd_kernel, hipFuncAttributeMaxDynamicSharedMemorySize, LDS_BYTES) != hipSuccess) { fprintf(stderr, "kernel_launch: hipFuncSetAttribute failed\n"); grid = -1; return; }
        if (hipOccupancyMaxActiveBlocksPerMultiprocessor(&per_cu, (const void*)fwd_kernel, NWAVES * 64, LDS_BYTES) != hipSuccess || per_cu < 1) { fprintf(stderr, "kernel_launch: occupancy query says %d\n", per_cu); per_cu = 1; }
        (void)hipGetLastError();
        grid = cus;
    }
    if (grid < 0) return;
    (void)hipMemsetAsync((char*)d_ws + WS_CTL, 0, CTL_ZERO_BYTES, stream);
    Args a{};
    for (int i = 0; i < 20; ++i) a.in[i] = (const float*)d_in[i];
    a.out = (float*)d_out; a.ws = (unsigned char*)d_ws; a.never = 0; a.pad = 0;
#if MK_N_LAUNCHES == 1
    a.ph_lo = 0; a.ph_hi = NPH;
    void* kargs[] = {&a};
    hipError_t e = hipLaunchCooperativeKernel((const void*)fwd_kernel, dim3(grid), dim3(NWAVES * 64), kargs, LDS_BYTES, stream);
    if (e != hipSuccess) fprintf(stderr, "kernel_launch: cooperative launch failed: %s (grid %d)\n", hipGetErrorString(e), grid);
#else
    for (int k = 0; k < NPH; ++k) { a.ph_lo = k; a.ph_hi = k + 1; hipLaunchKernelGGL(fwd_kernel, dim3(grid), dim3(NWAVES * 64), LDS_BYTES, stream, a); }
#endif
}
```

```cpp
#include <hip/hip_runtime.h>
#include <hip/hip_cooperative_groups.h>
#include <cstdio>
#include <cstdint>
namespace cg = cooperative_groups;
#define MK_N_LAUNCHES 1
namespace pg8 {
#define PG8_LAS __attribute__((address_space(3)))
typedef unsigned short bf16_t;
typedef short bf16x8 __attribute__((ext_vector_type(8)));
typedef float f32x4 __attribute__((ext_vector_type(4)));
typedef unsigned u32x4 __attribute__((ext_vector_type(4)));
constexpr int BM = 256, BK = 64, HALF = 128, HTB = HALF * BK * 2  , STAGE_BYTES = 8 * HTB, NXCD = 8, WGM = 8;

__host__ __device__ __forceinline__ int lds_byte(int r, int c) { const int st = (r >> 4) * 2 + (c >> 5), rr = r & 15, cc = c & 31, ob = rr * 64 + cc * 2; return st * 1024 + (ob ^ (((ob >> 9) & 1) << 5)); }
__host__ __device__ __forceinline__ void stage_rc(int b, int& R, int& C) { const int st = b / 1024, sb = b % 1024, swz = sb ^ (((sb >> 9) & 1) << 5); R = (st >> 1) * 16 + swz / 64; C = (st & 1) * 32 + (swz % 64) / 2; }
__host__ __device__ __forceinline__ int perm32(int rho) { const int n = rho >> 4, i = rho & 15; return 8 * (i >> 2) + 4 * n + (i & 3); }

struct Unit { int pm, pn; };
struct Gemm { const bf16_t* A; const bf16_t* Bt; int M, N, K; };

struct StaticOrder {
    int nM, nN, nwg, G, c;
    __host__ __device__ void init(int M, int N, int G_, int c_) { nM = M / BM; nN = N / BM; nwg = nM * nN; G = G_; c = c_; }
    __host__ __device__ bool next(int i, Unit& u) const {
        const long L = (long)i * G + c; if (L >= nwg) return false;
        int wgid = (int)L; { const int q = nwg / NXCD, r = nwg % NXCD, xcd = wgid % NXCD, off = wgid / NXCD; wgid = (xcd < r ? xcd * (q + 1) : r * (q + 1) + (xcd - r) * q) + off; }
        const int nig = WGM * nN, gid = wgid / nig, fm = gid * WGM, gsz = (nM - fm) < WGM ? (nM - fm) : WGM;
        u.pm = fm + ((wgid % nig) % gsz); u.pn = (wgid % nig) / gsz; return true;
    }
    __device__ __forceinline__ void a_ready(const Unit&) const {}
    __device__ __forceinline__ void done(const Unit&) const {}
};

__device__ __forceinline__ unsigned cvt_pk_bf16(float lo, float hi) { unsigned r; asm volatile("v_cvt_pk_bf16_f32 %0, %1, %2" : "=v"(r) : "v"(lo), "v"(hi)); return r; }
typedef float f32x2 __attribute__((ext_vector_type(2)));
__device__ __forceinline__ f32x2 gelu_pk(f32x2 v) {
    const f32x2 av = __builtin_elementwise_abs(v), d = av * 0.2316418882f + 1.0f;
    f32x2 t; t.x = __builtin_amdgcn_rcpf(d.x); t.y = __builtin_amdgcn_rcpf(d.y);
    f32x2 q = t * 0.5307027145f + (-0.7265760135f); q = q * t + 0.7107068705f; q = q * t + (-0.142248368f); q = q * t + 0.127414796f; q = q * t;
    const f32x2 s = (v * v) * (-0.72134752044f);
    f32x2 e; e.x = __builtin_amdgcn_exp2f(s.x); e.y = __builtin_amdgcn_exp2f(s.y);
    const f32x2 m = v * (q * e), r = v - m;
    f32x2 o; o.x = v.x < 0.f ? m.x : r.x; o.y = v.y < 0.f ? m.y : r.y; return o;
}

template <int ACT  > struct EpiBf16 {
    static constexpr bool PERM = true, AFTER_DRAIN = false; static_assert(ACT == 0 || ACT == 1, "EpiBf16: ACT is 0 (none) or 1 (gelu_pk)");
    bf16_t* O; int ldc; const float* bias; int split_cols; size_t split_stride; float scale0;
    __device__ __forceinline__ void operator()(const f32x4 (&acc)[2][2][4][2], const Unit& u, int wr, int wc, int fr, int fq) const {
        const int row0 = u.pm * BM + wr * 64 + fr; int colt = u.pn * BM; bf16_t* base = O;
        float sc = 1.f; if (split_cols) { const int t = colt / split_cols; base += (size_t)t * split_stride; colt -= t * split_cols; if (t == 0) sc = scale0; }
        const int col0 = colt + wc * 32 + 8 * fq, bcol0 = u.pn * BM + wc * 32 + 8 * fq;
        f32x4 bv[2][2];
#pragma unroll
        for (int bj = 0; bj < 2; ++bj)
#pragma unroll
            for (int n = 0; n < 2; ++n) bv[bj][n] = bias ? *(const f32x4*)(bias + bcol0 + bj * HALF + 4 * n) : (f32x4){0.f, 0.f, 0.f, 0.f};
#pragma unroll
        for (int ai = 0; ai < 2; ++ai)
#pragma unroll
            for (int m = 0; m < 4; ++m) { bf16_t* rowp = base + (size_t)(row0 + ai * HALF + m * 16) * ldc + col0;
#pragma unroll
                for (int bj = 0; bj < 2; ++bj) { f32x4 v0 = acc[ai][bj][m][0] + bv[bj][0], v1 = acc[ai][bj][m][1] + bv[bj][1];
                    if (ACT == 1) { f32x2 a = gelu_pk((f32x2){v0[0], v0[1]}), b = gelu_pk((f32x2){v0[2], v0[3]}), c = gelu_pk((f32x2){v1[0], v1[1]}), d = gelu_pk((f32x2){v1[2], v1[3]});
                        v0 = (f32x4){a.x, a.y, b.x, b.y}; v1 = (f32x4){c.x, c.y, d.x, d.y}; }
                    v0 = v0 * sc; v1 = v1 * sc; u32x4 w; w.x = cvt_pk_bf16(v0[0], v0[1]); w.y = cvt_pk_bf16(v0[2], v0[3]); w.z = cvt_pk_bf16(v1[0], v1[1]); w.w = cvt_pk_bf16(v1[2], v1[3]);
                    *(u32x4*)(rowp + bj * HALF) = w; } }
    }
};
template <class Epi, class Sched, bool ALIGN_EPI = false, bool SP2 = false>
__device__ __forceinline__ void gemm_phase(PG8_LAS unsigned char* lds, const Gemm g, const Sched& S, const Epi& E) {
    const int tid = threadIdx.x, wid = __builtin_amdgcn_readfirstlane(tid >> 6), lane = tid & 63, wr = wid >> 2, wc = wid & 3, fr = lane & 15, fq = lane >> 4;
    const int K = g.K, nt = K / BK;
    unsigned voffA[2], voffB[2];
#pragma unroll
    for (int i = 0; i < 2; ++i) { int R, C; stage_rc(tid * 16 + i * 8192, R, C); const int Rb = Epi::PERM ? ((R & ~31) + perm32(R & 31)) : R;
        voffA[i] = (unsigned)(R * K + C) * 2u; voffB[i] = (unsigned)(Rb * K + C) * 2u; }
    const size_t kstep = (size_t)(BK * 2);
    const size_t hstep = (size_t)HALF * K * 2;
    const size_t tstep = 2 * hstep;
    const unsigned ldsw = (unsigned)wid * 1024u;
    const int aoff = lds_byte(wr * 64 + fr, fq * 8), boff = lds_byte(wc * 32 + fr, fq * 8);
#define PG8_SA(b, h) (((b) * 2 + (h)) * HTB)
#define PG8_SB(b, h) ((4 + (b) * 2 + (h)) * HTB)
#define PG8_STAGE(bufoff, gbase, voff) do { _Pragma("unroll") for (int _i = 0; _i < 2; ++_i) \
        __builtin_amdgcn_global_load_lds((const unsigned*)((const char*)(gbase) + (voff)[_i]), (PG8_LAS unsigned*)(lds + (bufoff) + ldsw + _i * 8192), 16, 0, 0); } while (0)
#define PG8_LDA(dst, b, h) do { _Pragma("unroll") for (int m = 0; m < 4; ++m) _Pragma("unroll") for (int k = 0; k < 2; ++k) dst[m][k] = *(const PG8_LAS bf16x8*)(lds + PG8_SA(b, h) + aoff + m * 2048 + k * 1024); } while (0)
#define PG8_LDB(dst, b, h) do { _Pragma("unroll") for (int n = 0; n < 2; ++n) _Pragma("unroll") for (int k = 0; k < 2; ++k) dst[n][k] = *(const PG8_LAS bf16x8*)(lds + PG8_SB(b, h) + boff + n * 2048 + k * 1024); } while (0)
#define PG8_MMA(ai, bj, At, Bt) do { __builtin_amdgcn_s_setprio(1); _Pragma("unroll") for (int m = 0; m < 4; ++m) _Pragma("unroll") for (int n = 0; n < 2; ++n) _Pragma("unroll") for (int k = 0; k < 2; ++k) \
        acc[ai][bj][m][n] = __builtin_amdgcn_mfma_f32_16x16x32_bf16(Bt[n][k], At[m][k], acc[ai][bj][m][n], 0, 0, 0); __builtin_amdgcn_s_setprio(0); } while (0)
#define PG8_WAIT_V(n) asm volatile("s_waitcnt vmcnt(" #n ")" ::: "memory")
#define PG8_WAIT_L(n) asm volatile("s_waitcnt lgkmcnt(" #n ")" ::: "memory")
#define PG8_BAR __builtin_amdgcn_s_barrier()
#define PG8_SCHED __builtin_amdgcn_sched_barrier(0)
    Unit cur, nxt; int ui = 0;
    if (!S.next(0, cur)) return;
    f32x4 acc[2][2][4][2];
#pragma unroll
    for (int a = 0; a < 2; ++a)
#pragma unroll
        for (int b = 0; b < 2; ++b)
#pragma unroll
            for (int m = 0; m < 4; ++m)
#pragma unroll
                for (int n = 0; n < 2; ++n) acc[a][b][m][n] = (f32x4){0.f, 0.f, 0.f, 0.f};
    bf16x8 At[4][2], B0[2][2], B1[2][2];
    const char* cA = (const char*)g.A + (size_t)cur.pm * tstep; const char* cB = (const char*)g.Bt + (size_t)cur.pn * tstep;
    S.a_ready(cur);
    if constexpr (SP2) {
        PG8_STAGE(PG8_SB(0, 0), cB, voffB); PG8_STAGE(PG8_SB(0, 1), cB + hstep, voffB); PG8_STAGE(PG8_SA(0, 0), cA, voffA); PG8_STAGE(PG8_SA(0, 1), cA + hstep, voffA);
        if (wr == 1) PG8_BAR;
        PG8_WAIT_V(2); PG8_BAR;
        PG8_STAGE(PG8_SB(1, 0), cB + kstep, voffB); PG8_STAGE(PG8_SA(1, 0), cA + kstep, voffA); PG8_STAGE(PG8_SB(1, 1), cB + hstep + kstep, voffB);
        PG8_WAIT_V(6); PG8_BAR;
    } else {
        PG8_STAGE(PG8_SB(0, 0), cB, voffB); PG8_STAGE(PG8_SA(0, 0), cA, voffA); PG8_STAGE(PG8_SB(0, 1), cB + hstep, voffB); PG8_STAGE(PG8_SA(0, 1), cA + hstep, voffA);
        if (wr == 1) PG8_BAR;
        PG8_WAIT_V(4); PG8_BAR;
        PG8_STAGE(PG8_SB(1, 0), cB + kstep, voffB); PG8_STAGE(PG8_SA(1, 0), cA + kstep, voffA); PG8_STAGE(PG8_SB(1, 1), cB + hstep + kstep, voffB);
        PG8_WAIT_V(6); PG8_BAR;
    }
    for (;;) {
        const bool has_next = S.next(ui + 1, nxt);
        const char* nA = has_next ? (const char*)g.A + (size_t)nxt.pm * tstep : cA; const char* nB = has_next ? (const char*)g.Bt + (size_t)nxt.pn * tstep : cB;
        for (int t = 0; t < nt; t += 2) {
            const bool last = (t == nt - 2);
            const char* a1 = cA + (size_t)(t + 1) * kstep;
            const char* a2 = last ? nA : cA + (size_t)(t + 2) * kstep; const char* b2 = last ? nB : cB + (size_t)(t + 2) * kstep;
            const char* a3 = a2 + kstep; const char* b3 = b2 + kstep;
            if (last && has_next) S.a_ready(nxt);
            if constexpr (SP2) {
            PG8_LDB(B0, 0, 0); PG8_LDB(B1, 0, 1); PG8_SCHED; PG8_LDA(At, 0, 0); PG8_STAGE(PG8_SA(1, 1), a1 + hstep, voffA);
            PG8_WAIT_V(8); PG8_WAIT_L(0); PG8_BAR; PG8_MMA(0, 0, At, B0); PG8_MMA(0, 1, At, B1); PG8_BAR; PG8_SCHED;
            PG8_LDA(At, 0, 1); PG8_STAGE(PG8_SB(0, 0), b2, voffB); PG8_STAGE(PG8_SB(0, 1), b2 + hstep, voffB); PG8_STAGE(PG8_SA(0, 0), a2, voffA);
            PG8_WAIT_V(8); PG8_WAIT_L(0); PG8_BAR; PG8_MMA(1, 0, At, B0); PG8_MMA(1, 1, At, B1); PG8_BAR; PG8_SCHED;
            PG8_LDB(B0, 1, 0); PG8_LDB(B1, 1, 1); PG8_SCHED; PG8_LDA(At, 1, 0); PG8_STAGE(PG8_SA(0, 1), a2 + hstep, voffA);
            PG8_WAIT_V(8); PG8_WAIT_L(0); PG8_BAR; PG8_MMA(0, 0, At, B0); PG8_MMA(0, 1, At, B1); PG8_BAR; PG8_SCHED;
            PG8_LDA(At, 1, 1); PG8_STAGE(PG8_SB(1, 0), b3, voffB); PG8_STAGE(PG8_SB(1, 1), b3 + hstep, voffB); PG8_STAGE(PG8_SA(1, 0), a3, voffA);
            PG8_WAIT_V(8); PG8_WAIT_L(0); PG8_BAR; PG8_MMA(1, 0, At, B0); PG8_MMA(1, 1, At, B1); PG8_BAR; PG8_SCHED;
            } else {
            PG8_LDB(B0, 0, 0); PG8_SCHED; PG8_LDA(At, 0, 0); PG8_STAGE(PG8_SA(1, 1), a1 + hstep, voffA);
            PG8_WAIT_L(8); PG8_BAR; PG8_WAIT_L(0); PG8_MMA(0, 0, At, B0); PG8_BAR; PG8_SCHED;
            PG8_LDB(B1, 0, 1); PG8_STAGE(PG8_SB(0, 0), b2, voffB);
            PG8_BAR; PG8_WAIT_L(0); PG8_MMA(0, 1, At, B1); PG8_BAR;
            PG8_LDA(At, 0, 1); PG8_STAGE(PG8_SA(0, 0), a2, voffA);
            PG8_BAR; PG8_WAIT_L(0); PG8_MMA(1, 0, At, B0); PG8_BAR; PG8_SCHED;
            PG8_STAGE(PG8_SB(0, 1), b2 + hstep, voffB);
            PG8_WAIT_V(6); PG8_BAR; PG8_MMA(1, 1, At, B1); PG8_BAR;
            PG8_LDB(B0, 1, 0); PG8_SCHED; PG8_LDA(At, 1, 0); PG8_STAGE(PG8_SA(0, 1), a2 + hstep, voffA);
            PG8_WAIT_L(8); PG8_BAR; PG8_WAIT_L(0); PG8_MMA(0, 0, At, B0); PG8_BAR; PG8_SCHED;
            PG8_LDB(B1, 1, 1); PG8_STAGE(PG8_SB(1, 0), b3, voffB);
            PG8_BAR; PG8_WAIT_L(0); PG8_MMA(0, 1, At, B1); PG8_BAR;
            PG8_LDA(At, 1, 1); PG8_STAGE(PG8_SA(1, 0), a3, voffA);
            PG8_BAR; PG8_WAIT_L(0); PG8_MMA(1, 0, At, B0); PG8_BAR; PG8_SCHED;
            PG8_STAGE(PG8_SB(1, 1), b3 + hstep, voffB);
            PG8_WAIT_V(6); PG8_BAR; PG8_MMA(1, 1, At, B1); PG8_BAR;
            }
        }
        if constexpr (ALIGN_EPI) { if (wr == 0) PG8_BAR; }
        if constexpr (!Epi::AFTER_DRAIN) { E(acc, cur, wr, wc, fr, fq); S.done(cur); }
        if (!has_next) break;
#pragma unroll
        for (int a = 0; a < 2; ++a)
#pragma unroll
            for (int b = 0; b < 2; ++b)
#pragma unroll
                for (int m = 0; m < 4; ++m)
#pragma unroll
                    for (int n = 0; n < 2; ++n) acc[a][b][m][n] = (f32x4){0.f, 0.f, 0.f, 0.f};
        cur = nxt; cA = nA; cB = nB; ++ui;
        if constexpr (ALIGN_EPI) { if (wr == 1) PG8_BAR; }
    }
    PG8_WAIT_V(0);
    if constexpr (!ALIGN_EPI) { if (wr == 0) PG8_BAR; }
    PG8_BAR;
    if constexpr (Epi::AFTER_DRAIN) { E.fused(acc, cur, wr, wc, fr, fq, lds, wid, lane); S.done(cur); }
#undef PG8_SA
#undef PG8_SB
#undef PG8_STAGE
#undef PG8_LDA
#undef PG8_LDB
#undef PG8_MMA
#undef PG8_WAIT_V
#undef PG8_WAIT_L
#undef PG8_BAR
#undef PG8_SCHED
}
}
#define GAS __attribute__((address_space(1)))
#define LAS __attribute__((address_space(3)))
typedef unsigned short bf16;
typedef unsigned v4u __attribute__((ext_vector_type(4)));
typedef float f32x4 __attribute__((ext_vector_type(4)));
typedef short bf16x8 __attribute__((ext_vector_type(8)));
typedef GAS unsigned gu32;
typedef GAS unsigned long long gu64;
#define RLX_AGENT __ATOMIC_RELAXED, __HIP_MEMORY_SCOPE_AGENT
#define LDS_WAIT() asm volatile("s_waitcnt lgkmcnt(0)" ::: "memory")
#define VM_WAIT() asm volatile("s_waitcnt vmcnt(0)" ::: "memory")
__device__ __forceinline__ unsigned long long rt() { return __builtin_amdgcn_s_memrealtime(); }
__device__ __forceinline__ unsigned f2bf(float f) { unsigned u = __builtin_bit_cast(unsigned, f); return (u + 0x7fffu + ((u >> 16) & 1u)) >> 16; }
__device__ __forceinline__ unsigned pk2(float lo, float hi) { return f2bf(lo) | (f2bf(hi) << 16); }
#define XB_TMO      128
#define XB_XCNT(j)  (256  + 64 * (j))
#define XB_XSUB(j)  (1280 + 64 * (j))
#define XB_XGEN(j)  (2304 + 64 * (j))
#define XB_TOP      3328
#define XB_TOPGEN   3392
#define XCD_BAR_WORDS 3456
#define XB_SPIN_CAP (1u << 18)

__device__ __forceinline__ unsigned xb_ld(unsigned* p)              { return __hip_atomic_load(p, __ATOMIC_RELAXED, __HIP_MEMORY_SCOPE_AGENT); }
__device__ __forceinline__ unsigned xb_add(unsigned* p, unsigned v) { return __hip_atomic_fetch_add(p, v, __ATOMIC_RELAXED, __HIP_MEMORY_SCOPE_AGENT); }
__device__ __forceinline__ unsigned xb_xcc_id() { return (unsigned)__builtin_amdgcn_s_getreg((3 << 11) | 20) & 0xFu; }
#define XB_SPIN(cond, bar) do { unsigned _sp = 0; while (cond) { __builtin_amdgcn_s_sleep(1); \
    if ((++_sp & 255u) == 0u) { if (xb_ld(&(bar)[XB_TMO])) break; if (_sp > XB_SPIN_CAP) { atomicAdd(&(bar)[XB_TMO], 1u); break; } } } } while (0)

struct XcdBarrier {
    unsigned* bar; unsigned x;
    volatile LAS unsigned* st;
};

__device__ __forceinline__ XcdBarrier xcd_barrier_post(unsigned* bar, volatile LAS unsigned* st) {
    XcdBarrier b; b.bar = bar; b.x = xb_xcc_id(); b.st = st;
    if (threadIdx.x == 0) (void)xb_add(&bar[XB_XCNT(b.x)], 1u);
    return b;
}
__device__ __forceinline__ void xcd_barrier_complete(unsigned* bar, unsigned x, unsigned& nloc, unsigned& nx) {
    const unsigned G = gridDim.x * gridDim.y * gridDim.z;
    unsigned sum, cnt, mine, sp = 0u;
    for (;;) {
        sum = 0u; cnt = 0u; mine = 0u;
#pragma unroll
        for (unsigned j = 0; j < 16; ++j) { const unsigned c = xb_ld(&bar[XB_XCNT(j)]); sum += c; cnt += (c > 0u) ? 1u : 0u; mine = (j == x) ? c : mine; }
        if (sum == G) break;
        __builtin_amdgcn_s_sleep(1);
        if ((++sp & 255u) == 0u) { if (xb_ld(&bar[XB_TMO])) break; if (sp > XB_SPIN_CAP) { atomicAdd(&bar[XB_TMO], 1u); break; } }
    }
    nloc = mine > 0u ? mine : 1u; nx = cnt > 0u ? cnt : 1u;
}

__device__ __forceinline__ void xcd_barrier(const XcdBarrier& b) {
    asm volatile("s_waitcnt vmcnt(0)" ::: "memory");
    __syncthreads();
    if (threadIdx.x == 0) {
        unsigned* bar = b.bar;
        __builtin_amdgcn_s_waitcnt(0);
        unsigned nloc = b.st[0], nx = b.st[1];
        if (nloc == 0u) { xcd_barrier_complete(bar, b.x, nloc, nx); b.st[0] = nloc; b.st[1] = nx; }
        const unsigned old = xb_add(&bar[XB_XSUB(b.x)], 1u);
        const unsigned gen = old / nloc;
        if (old + 1u == (gen + 1u) * nloc) {
            __builtin_amdgcn_fence(__ATOMIC_RELEASE, "agent");
            asm volatile("s_waitcnt vmcnt(0)" ::: "memory");
            const unsigned og = xb_add(&bar[XB_TOP], 1u);
            const unsigned tg = og / nx;
            if (og + 1u == (tg + 1u) * nx) xb_add(&bar[XB_TOPGEN], 1u);
            else XB_SPIN(xb_ld(&bar[XB_TOPGEN]) == tg, bar);
            __builtin_amdgcn_fence(__ATOMIC_ACQUIRE, "agent");
            xb_add(&bar[XB_XGEN(b.x)], 1u);
            asm volatile("s_waitcnt vmcnt(0)" ::: "memory");
        } else {
            XB_SPIN(xb_ld(&bar[XB_XGEN(b.x)]) == gen, bar);
            __builtin_amdgcn_fence(__ATOMIC_ACQUIRE, "agent");
            asm volatile("s_waitcnt vmcnt(0)" ::: "memory");
        }
    }
    __syncthreads();
}
typedef unsigned u32x4 __attribute__((ext_vector_type(4)));
__device__ __forceinline__ float wave_sum(float v) {
#pragma unroll
    for (int o = 1; o < 64; o <<= 1) v += __shfl_xor(v, o);
    return v;
}

constexpr int NWAVES = 8;
constexpr int MP = 16384, MS = 128, M = MP + MS, MPAD = 16640;
constexpr int SEQ = 8192;
constexpr int D = 1024, NPROJ = 4352, DATT = 512, DC = 512, FF = 2816;
constexpr int C_Q = 0, C_K = 512, C_V = 640, C_CB = 768, C_CC = 1280, C_CH = 1792, C_GA = 2304, C_GB = 3328;
constexpr float LN_EPS = 1e-5f;
constexpr float DN_ALPHA = 1.189207115002721f;
constexpr size_t O_YP = 0, O_YS = 16777216, O_KP = O_YS + 131072, O_VP = O_KP + 32768, O_CP = O_VP + 32768, O_FP = O_CP + 2048,
                 O_KS = O_FP + 11264, O_VS = O_KS + 2097152, O_CS = O_VS + 2097152, O_FS = O_CS + 131072, O_END = O_FS + 720896;
constexpr size_t MiB = 1u << 20;
constexpr size_t WS_CTL = 0, CTL_ZERO_BYTES = 64 * 1024;
constexpr size_t WS_WIN = 1 * MiB;
constexpr size_t WS_WAO = WS_WIN + (size_t)NPROJ * D * 2;
constexpr size_t WS_WCO = WS_WAO + (size_t)D * DATT * 2;
constexpr size_t WS_WMIX = WS_WCO + (size_t)D * DC * 2;
constexpr size_t WS_WGU = WS_WMIX + (size_t)D * D * 2;
constexpr size_t WS_WD = WS_WGU + (size_t)2 * FF * D * 2;
constexpr size_t WS_A = 32 * MiB;
constexpr size_t WS_B = WS_A + (size_t)MPAD * D * 2;
constexpr size_t WS_OATT = WS_B, WS_Z = WS_B + (size_t)MPAD * DATT * 2;
constexpr size_t WS_H2 = WS_A;
constexpr size_t WS_C = WS_B + (size_t)MPAD * D * 2;
constexpr size_t WS_P = WS_C;
constexpr size_t WS_X1 = WS_C;
constexpr size_t WS_H1 = WS_X1 + (size_t)MPAD * D * 2;
constexpr size_t WS_ACT = WS_H1;
constexpr size_t WS_HB = WS_C + (size_t)MPAD * NPROJ * 2;
constexpr size_t WS_END = WS_HB + (size_t)260 * 6 * FF * 4;
static_assert(WS_WD + (size_t)D * FF * 2 <= WS_A, "weights fit below 32 MiB");
static_assert(WS_ACT + (size_t)MPAD * FF * 2 <= WS_HB, "ACT fits in the P region");
static_assert(WS_END <= 256 * MiB, "workspace");
constexpr int CW_BAR = 1024;
constexpr int RING_BYTES = 131072, MISC_OFF = RING_BYTES, LDS_BYTES = RING_BYTES + 512;

using pg8::bf16_t; using pg8::Unit;
typedef unsigned u32x2 __attribute__((ext_vector_type(2)));
typedef float f32x16 __attribute__((ext_vector_type(16)));
constexpr int BM = 256, HALF = 128;

__device__ __forceinline__ float bf_lo(unsigned u) { return __uint_as_float(u << 16); }
__device__ __forceinline__ float bf_hi(unsigned u) { return __uint_as_float(u & 0xffff0000u); }
__device__ __forceinline__ float bf1(bf16_t h) { return __uint_as_float((unsigned)h << 16); }
__device__ __forceinline__ float sigm(float x) { return __builtin_amdgcn_rcpf(1.f + __expf(-x)); }
__device__ __forceinline__ unsigned cvtpk(float lo, float hi) { return pg8::cvt_pk_bf16(lo, hi); }
template <int CTRL> __device__ __forceinline__ float dppf(float x) { return __builtin_bit_cast(float, __builtin_amdgcn_update_dpp(0, __builtin_bit_cast(int, x), CTRL, 0xf, 0xf, false)); }
template <int CTRL> __device__ __forceinline__ f32x4 dpp4(f32x4 v) { f32x4 r; r[0] = dppf<CTRL>(v[0]); r[1] = dppf<CTRL>(v[1]); r[2] = dppf<CTRL>(v[2]); r[3] = dppf<CTRL>(v[3]); return r; }
__device__ __forceinline__ f32x4 gelu4(f32x4 v) { pg8::f32x2 a = pg8::gelu_pk((pg8::f32x2){v[0], v[1]}), b = pg8::gelu_pk((pg8::f32x2){v[2], v[3]}); return (f32x4){a.x, a.y, b.x, b.y}; }

template <int PASS> struct EpiGate {
    static constexpr bool PERM = true, AFTER_DRAIN = false;
    const bf16_t* P; bf16_t* MG;
    __device__ __forceinline__ void operator()(const f32x4 (&acc)[2][2][4][2], const Unit& u, int wr, int wc, int fr, int fq) const {
        const int row0 = u.pm * BM + wr * 64 + fr, col0 = u.pn * BM + wc * 32 + 8 * fq;
#pragma unroll
        for (int ai = 0; ai < 2; ++ai)
#pragma unroll
            for (int m = 0; m < 4; ++m) { const size_t row = (size_t)(row0 + ai * HALF + m * 16);
#pragma unroll
                for (int bj = 0; bj < 2; ++bj) { const int col = col0 + bj * HALF;
                    const u32x4 g = *(const u32x4*)(P + row * NPROJ + (PASS == 0 ? C_GA : C_GB) + col);
                    f32x4 v0 = acc[ai][bj][m][0], v1 = acc[ai][bj][m][1];
                    v0[0] *= sigm(bf_lo(g.x)); v0[1] *= sigm(bf_hi(g.x)); v0[2] *= sigm(bf_lo(g.y)); v0[3] *= sigm(bf_hi(g.y));
                    v1[0] *= sigm(bf_lo(g.z)); v1[1] *= sigm(bf_hi(g.z)); v1[2] *= sigm(bf_lo(g.w)); v1[3] *= sigm(bf_hi(g.w));
                    bf16_t* o = MG + row * D + col;
                    if (PASS == 1) { const u32x4 t = *(const u32x4*)o;
                        v0[0] += bf_lo(t.x); v0[1] += bf_hi(t.x); v0[2] += bf_lo(t.y); v0[3] += bf_hi(t.y);
                        v1[0] += bf_lo(t.z); v1[1] += bf_hi(t.z); v1[2] += bf_lo(t.w); v1[3] += bf_hi(t.w); }
                    u32x4 w; w.x = cvtpk(v0[0], v0[1]); w.y = cvtpk(v0[2], v0[3]); w.z = cvtpk(v1[0], v1[1]); w.w = cvtpk(v1[2], v1[3]);
                    *(u32x4*)o = w; } }
    }
};
struct EpiResX {
    static constexpr bool PERM = false, AFTER_DRAIN = false;
    const float* xp; const float* xs; float* H;
    __device__ __forceinline__ void operator()(const f32x4 (&acc)[2][2][4][2], const Unit& u, int wr, int wc, int fr, int fq) const {
#pragma unroll
        for (int ai = 0; ai < 2; ++ai) { const int rb = u.pm * BM + ai * HALF; if (rb >= M) continue;
            const float* xb = rb < MP ? xp + (size_t)rb * D : xs + (size_t)(rb - MP) * D; float* hb = H + (size_t)rb * D;
#pragma unroll
            for (int m = 0; m < 4; ++m) { const size_t ro = (size_t)(wr * 64 + m * 16 + fr) * D;
#pragma unroll
                for (int bj = 0; bj < 2; ++bj)
#pragma unroll
                    for (int n = 0; n < 2; ++n) { const int col = u.pn * BM + bj * HALF + wc * 32 + n * 16 + 4 * fq;
                        const f32x4 xv = *(const f32x4*)(xb + ro + col); *(f32x4*)(hb + ro + col) = xv * DN_ALPHA + acc[ai][bj][m][n]; } } }
    }
};
struct EpiResB {
    static constexpr bool PERM = false, AFTER_DRAIN = false;
    const bf16_t* X1; float* H;
    __device__ __forceinline__ void operator()(const f32x4 (&acc)[2][2][4][2], const Unit& u, int wr, int wc, int fr, int fq) const {
#pragma unroll
        for (int ai = 0; ai < 2; ++ai) { const int rb = u.pm * BM + ai * HALF; if (rb >= M) continue;
#pragma unroll
            for (int m = 0; m < 4; ++m) { const size_t ro = (size_t)(rb + wr * 64 + m * 16 + fr) * D;
#pragma unroll
                for (int bj = 0; bj < 2; ++bj)
#pragma unroll
                    for (int n = 0; n < 2; ++n) { const int col = u.pn * BM + bj * HALF + wc * 32 + n * 16 + 4 * fq;
                        const u32x2 xv = *(const u32x2*)(X1 + ro + col); const f32x4 x4 = {bf_lo(xv.x), bf_hi(xv.x), bf_lo(xv.y), bf_hi(xv.y)};
                        *(f32x4*)(H + ro + col) = x4 * DN_ALPHA + acc[ai][bj][m][n]; } } }
    }
};
struct EpiGU {
    static constexpr bool PERM = true, AFTER_DRAIN = false;
    bf16_t* ACT; float* HB; const float* cw; const float* stf; float* out;
    __device__ __forceinline__ void operator()(const f32x4 (&acc)[2][2][4][2], const Unit& u, int wr, int wc, int fr_, int fq_) const {
        int fr = fr_, fq = fq_; asm volatile("" : "+v"(fr), "+v"(fq));
#pragma unroll
        for (int n = 0; n < 2; ++n) {
            const int c0 = u.pn * HALF + wc * 32 + 8 * fq + 4 * n;
            const f32x4 w0 = *(const f32x4*)(cw + c0), w1 = *(const f32x4*)(cw + FF + c0), w2 = *(const f32x4*)(cw + 2 * FF + c0);
            if (u.pm < MP / BM) {
#pragma unroll
                for (int ai = 0; ai < 2; ++ai) { const int rbase = u.pm * BM + ai * HALF + wr * 64; const int G = rbase >> 6;
                    float* hb = HB + (size_t)G * 6 * FF + c0;
                    const bool lastg = ((rbase + 64) & (SEQ - 1)) == 0;
#pragma unroll
                    for (int m = 0; m < 4; ++m) { const size_t row = (size_t)(rbase + m * 16 + fr);
                        const f32x4 cur = acc[ai][0][m][n], upv = acc[ai][1][m][n];
                        f32x4 g1 = dpp4<0x121>(cur), g2 = dpp4<0x122>(cur);
                        if (m > 0) { const f32x4 p1 = dpp4<0x121>(acc[ai][0][m - 1][n]), p2 = dpp4<0x122>(acc[ai][0][m - 1][n]); if (fr < 1) g1 = p1; if (fr < 2) g2 = p2; }
                        const f32x4 a = gelu4(w0 * g2 + w1 * g1 + w2 * cur) * upv;
                        u32x2 w; w.x = cvtpk(a[0], a[1]); w.y = cvtpk(a[2], a[3]);
                        if (m == 0 && fr < 2) { *(f32x4*)(hb + (size_t)fr * FF) = cur; *(f32x4*)(hb + (size_t)(4 + fr) * FF) = upv; }
                        if (m == 3 && fr >= 14) { *(f32x4*)(hb + (size_t)(2 + fr - 14) * FF) = cur;
                            if (lastg) *(f32x4*)(out + O_FP + (size_t)((rbase >> 13) * 2 + fr - 14) * FF + c0) = cur; }
                        if (!(m == 0 && fr < 2)) *(u32x2*)(ACT + row * FF + c0) = w; } }
            } else {
#pragma unroll
                for (int m = 0; m < 4; ++m) { const int ns = wr * 64 + m * 16 + fr;
                    const f32x4 cur = acc[0][0][m][n], upv = acc[0][1][m][n];
                    const f32x4 g2 = *(const f32x4*)(stf + (size_t)(ns * 2 + 0) * FF + c0), g1 = *(const f32x4*)(stf + (size_t)(ns * 2 + 1) * FF + c0);
                    const f32x4 a = gelu4(w0 * g2 + w1 * g1 + w2 * cur) * upv;
                    u32x2 w; w.x = cvtpk(a[0], a[1]); w.y = cvtpk(a[2], a[3]);
                    *(f32x4*)(out + O_FS + (size_t)(ns * 2 + 0) * FF + c0) = g1; *(f32x4*)(out + O_FS + (size_t)(ns * 2 + 1) * FF + c0) = cur;
                    *(u32x2*)(ACT + (size_t)(MP + ns) * FF + c0) = w; }
            }
            __builtin_amdgcn_sched_barrier(0);
        }
    }
};

__device__ __forceinline__ void p0_item(const float* W, int K, int N, bf16* WT, int mode, LAS float* scr, int item, int lane) {
    const int nblk = N / 32, kb = item / nblk, nb = item % nblk, k0 = 64 * kb, n0 = 32 * nb;
    const int drow = mode == 0 ? n0 : 256 * (n0 >> 7) + (n0 & 127) + (mode == 2 ? 128 : 0);
#pragma unroll 8
    for (int i = 0; i < 32; ++i) { const int kk = 2 * i + (lane >> 5); scr[kk * 33 + (lane & 31)] = W[(size_t)(k0 + kk) * N + n0 + (lane & 31)]; }
    LDS_WAIT(); asm volatile("" ::: "memory");
    const int c = lane & 7;
#pragma unroll
    for (int j = 0; j < 4; ++j) { const int n = (lane >> 3) + 8 * j; const LAS float* s = scr + (8 * c) * 33 + n;
        v4u o; o.x = pk2(s[0 * 33], s[1 * 33]); o.y = pk2(s[2 * 33], s[3 * 33]); o.z = pk2(s[4 * 33], s[5 * 33]); o.w = pk2(s[6 * 33], s[7 * 33]);
        *(GAS v4u*)(WT + (size_t)(drow + n) * K + k0 + 8 * c) = o; }
    LDS_WAIT(); asm volatile("" ::: "memory");
}
struct In { const float *xp, *xs, *ck, *cv, *stc, *stf, *w_in, *conv_w, *sinks, *w_ao, *w_co, *w_mix, *ln1g, *ln1b, *w_gate, *w_up, *fcw, *w_down, *ln2g, *ln2b; };

__device__ __forceinline__ void p0_prologue(const In& I, unsigned char* ws, LAS unsigned char* lds, int gw, int NGW, int wave, int lane) {
    LAS float* scr = (LAS float*)(lds + wave * 16384);
    constexpr int I_IN = (D / 64) * (NPROJ / 32), I_AO = (DATT / 64) * (D / 32), I_MIX = (D / 64) * (D / 32), I_G = (D / 64) * (FF / 32), I_D = (FF / 64) * (D / 32);
    constexpr int NITEMS = I_IN + 2 * I_AO + I_MIX + 2 * I_G + I_D;
    for (int it = gw; it < NITEMS; it += NGW) {
        int r = it;
        if (r < I_IN) { p0_item(I.w_in, D, NPROJ, (bf16*)(ws + WS_WIN), 0, scr, r, lane); continue; } r -= I_IN;
        if (r < I_AO) { p0_item(I.w_ao, DATT, D, (bf16*)(ws + WS_WAO), 0, scr, r, lane); continue; } r -= I_AO;
        if (r < I_AO) { p0_item(I.w_co, DC, D, (bf16*)(ws + WS_WCO), 0, scr, r, lane); continue; } r -= I_AO;
        if (r < I_MIX) { p0_item(I.w_mix, D, D, (bf16*)(ws + WS_WMIX), 0, scr, r, lane); continue; } r -= I_MIX;
        if (r < I_G) { p0_item(I.w_gate, D, FF, (bf16*)(ws + WS_WGU), 1, scr, r, lane); continue; } r -= I_G;
        if (r < I_G) { p0_item(I.w_up, D, FF, (bf16*)(ws + WS_WGU), 2, scr, r, lane); continue; } r -= I_G;
        p0_item(I.w_down, FF, D, (bf16*)(ws + WS_WD), 0, scr, r, lane);
    }
    bf16* XB = (bf16*)(ws + WS_A);
    for (int m = gw; m < MPAD; m += NGW) {
        GAS unsigned long long* o8 = (GAS unsigned long long*)(XB + (size_t)m * D) + lane;
        if (m < M) { const float* xr = m < MP ? I.xp + (size_t)m * D : I.xs + (size_t)(m - MP) * D; const GAS f32x4* x4 = (const GAS f32x4*)xr + lane;
#pragma unroll
            for (int j = 0; j < 4; ++j) { const f32x4 v = x4[64 * j]; o8[64 * j] = (unsigned long long)pk2(v.x, v.y) | ((unsigned long long)pk2(v.z, v.w) << 32); }
        } else {
#pragma unroll
            for (int j = 0; j < 4; ++j) o8[64 * j] = 0ull;
        }
    }
}

typedef short s16x8 __attribute__((ext_vector_type(8)));
__device__ __forceinline__ void attn_prompt_unit(LAS unsigned char* lds, const bf16_t* P, bf16_t* OA, const float* sinks, int b, int i, int kvh, int tid) {
    LAS bf16_t* Ks = (LAS bf16_t*)lds;
    LAS bf16_t* VT = (LAS bf16_t*)(lds + 36864);
    const int lane = tid & 63, w = tid >> 6, l31 = lane & 31, hi = lane >> 5;
    const long rowbase = (long)b * SEQ + (long)(i - 1) * 128;
#pragma unroll
    for (int it = 0; it < 4; ++it) { const int ch = tid + it * 512, j = ch >> 3, c = ch & 7;
        const int jj = (i == 0 && j < 128) ? j + 128 : j;
        const bf16_t* src = P + (size_t)(rowbase + jj) * NPROJ + C_K + kvh * 64 + c * 8;
        const u32x4 kv = *(const u32x4*)src; const u32x4 vv = *(const u32x4*)(src + (C_V - C_K));
        *(LAS u32x4*)(Ks + j * 72 + c * 8) = kv;
        LAS bf16_t* vt = VT + (c * 8) * 260 + j;
        vt[0 * 260] = (bf16_t)(vv.x & 0xffffu); vt[1 * 260] = (bf16_t)(vv.x >> 16); vt[2 * 260] = (bf16_t)(vv.y & 0xffffu); vt[3 * 260] = (bf16_t)(vv.y >> 16);
        vt[4 * 260] = (bf16_t)(vv.z & 0xffffu); vt[5 * 260] = (bf16_t)(vv.z >> 16); vt[6 * 260] = (bf16_t)(vv.w & 0xffffu); vt[7 * 260] = (bf16_t)(vv.w >> 16); }
    __syncthreads();
    const int g = w >> 1, h = kvh * 4 + g;
    const float slope = exp2f(-(float)(h + 1)), sink = sinks[h];
#pragma unroll 1
    for (int t = 0; t < 2; ++t) {
        const int a0 = 64 * (w & 1) + 32 * t;
        const size_t qrow = (size_t)b * SEQ + (size_t)i * 128 + a0 + l31;
        s16x8 Bq[4];
#pragma unroll
        for (int s = 0; s < 4; ++s) Bq[s] = *(const s16x8*)(P + qrow * NPROJ + C_Q + h * 64 + 16 * s + 8 * hi);
        f32x16 S[5];
#pragma unroll
        for (int jt = 0; jt < 5; ++jt) {
#pragma unroll
            for (int r = 0; r < 16; ++r) S[jt][r] = 0.f;
#pragma unroll
            for (int s = 0; s < 4; ++s) { const s16x8 A = *(const LAS s16x8*)(Ks + (a0 + 32 * jt + l31) * 72 + 16 * s + 8 * hi);
                S[jt] = __builtin_amdgcn_mfma_f32_32x32x16_bf16(A, Bq[s], S[jt], 0, 0, 0); }
            __builtin_amdgcn_sched_barrier(0); }
        float mx = -1e30f;
        float basef = (float)(128 + l31 - 4 * hi), ubf = (i > 0) ? 128.f : fminf(128.f, (float)(l31 + a0));
        asm volatile("" : "+v"(basef), "+v"(ubf));
#pragma unroll
        for (int jt = 0; jt < 5; ++jt) {
#pragma unroll
            for (int r = 0; r < 16; ++r) { const float dist = basef - (float)(32 * jt + (r & 3) + 8 * (r >> 2));
                const bool valid = (dist >= 0.f) && (dist <= ubf);
                const float sv = valid ? S[jt][r] * 0.125f - slope * dist : -1e30f; S[jt][r] = sv; mx = fmaxf(mx, sv); }
            __builtin_amdgcn_sched_barrier(0); }
        mx = fmaxf(mx, __shfl_xor(mx, 32)); mx = fmaxf(mx, sink);
        float sum = 0.f;
#pragma unroll
        for (int jt = 0; jt < 5; ++jt) {
#pragma unroll
            for (int r = 0; r < 16; ++r) { const float p = __expf(S[jt][r] - mx); S[jt][r] = p; sum += p; }
            __builtin_amdgcn_sched_barrier(0); }
        sum += __shfl_xor(sum, 32);
        const float inv = 1.f / (sum + __expf(sink - mx));
        f32x16 O[2];
#pragma unroll
        for (int dt = 0; dt < 2; ++dt)
#pragma unroll
            for (int r = 0; r < 16; ++r) O[dt][r] = 0.f;
#pragma unroll
        for (int jt = 0; jt < 5; ++jt)
#pragma unroll
            for (int s2 = 0; s2 < 2; ++s2) {
                u32x4 pb; pb.x = cvtpk(S[jt][8 * s2 + 0], S[jt][8 * s2 + 1]); pb.y = cvtpk(S[jt][8 * s2 + 2], S[jt][8 * s2 + 3]); pb.z = cvtpk(S[jt][8 * s2 + 4], S[jt][8 * s2 + 5]); pb.w = cvtpk(S[jt][8 * s2 + 6], S[jt][8 * s2 + 7]);
                const s16x8 Bp = __builtin_bit_cast(s16x8, pb);
                const int kb = a0 + 32 * jt + 16 * s2 + 4 * hi;
#pragma unroll
                for (int dt = 0; dt < 2; ++dt) { const LAS bf16_t* vp = VT + (32 * dt + l31) * 260 + kb;
                    u32x4 av; const u32x2 lo = *(const LAS u32x2*)vp, hi2 = *(const LAS u32x2*)(vp + 8); av.x = lo.x; av.y = lo.y; av.z = hi2.x; av.w = hi2.y;
                    O[dt] = __builtin_amdgcn_mfma_f32_32x32x16_bf16(__builtin_bit_cast(s16x8, av), Bp, O[dt], 0, 0, 0); }
                __builtin_amdgcn_sched_barrier(0); }
        bf16_t* orow = OA + qrow * DATT + h * 64;
#pragma unroll
        for (int dt = 0; dt < 2; ++dt)
#pragma unroll
            for (int gq = 0; gq < 4; ++gq) { u32x2 o; o.x = cvtpk(O[dt][4 * gq + 0] * inv, O[dt][4 * gq + 1] * inv); o.y = cvtpk(O[dt][4 * gq + 2] * inv, O[dt][4 * gq + 3] * inv);
                *(u32x2*)(orow + 32 * dt + 8 * gq + 4 * hi) = o; }
    }
    __syncthreads();
}
__device__ __forceinline__ void attn_sample_unit(LAS unsigned char* lds, const bf16_t* P, bf16_t* OA, const float* ck, const float* cv, const float* sinks, float* out, int n, int kvh, int tid) {
    LAS float* Ks = (LAS float*)lds;
    LAS float* Vs = (LAS float*)(lds + 33792);
    LAS float* qs = (LAS float*)(lds + 67584);
    LAS float* sc = (LAS float*)(lds + 68608);
    const int lane = tid & 63, w = tid >> 6;
#pragma unroll
    for (int it = 0; it < 4; ++it) { const int idx = tid + it * 512, s = idx >> 4, c4 = (idx & 15) * 4;
        const size_t off = ((size_t)(n * 128 + s) * 2 + kvh) * 64 + c4;
        const f32x4 kk = *(const f32x4*)(ck + off), vv = *(const f32x4*)(cv + off);
        Ks[s * 65 + c4 + 0] = kk.x; Ks[s * 65 + c4 + 1] = kk.y; Ks[s * 65 + c4 + 2] = kk.z; Ks[s * 65 + c4 + 3] = kk.w;
        Vs[s * 65 + c4 + 0] = vv.x; Vs[s * 65 + c4 + 1] = vv.y; Vs[s * 65 + c4 + 2] = vv.z; Vs[s * 65 + c4 + 3] = vv.w;
        if (s >= 1) { *(f32x4*)(out + O_KS + off - 128) = kk; *(f32x4*)(out + O_VS + off - 128) = vv; } }
    const bf16_t* prow = P + (size_t)(MP + n) * NPROJ;
    if (tid < 64) { const float kn = bf1(prow[C_K + kvh * 64 + tid]), vn = bf1(prow[C_V + kvh * 64 + tid]);
        Ks[128 * 65 + tid] = kn; Vs[128 * 65 + tid] = vn;
        const size_t off = ((size_t)(n * 128 + 127) * 2 + kvh) * 64 + tid; out[O_KS + off] = kn; out[O_VS + off] = vn; }
    if (tid < 256) qs[tid] = bf1(prow[C_Q + kvh * 256 + tid]);
    __syncthreads();
    for (int idx = tid; idx < 4 * 129; idx += 512) { const int g = idx / 129, s = idx - g * 129; float dot = 0.f;
#pragma unroll 8
        for (int d = 0; d < 64; ++d) dot += qs[g * 64 + d] * Ks[s * 65 + d];
        sc[g * 132 + s] = dot * 0.125f - exp2f(-(float)(kvh * 4 + g + 1)) * (float)(128 - s); }
    __syncthreads();
    if (w < 4) { const float sink = sinks[kvh * 4 + w];
        const float s0 = sc[w * 132 + lane], s1 = sc[w * 132 + 64 + lane], s2 = lane == 0 ? sc[w * 132 + 128] : -1e30f;
        float mx = fmaxf(fmaxf(s0, s1), s2);
#pragma unroll
        for (int o = 1; o < 64; o <<= 1) mx = fmaxf(mx, __shfl_xor(mx, o));
        mx = fmaxf(mx, sink);
        const float p0 = __expf(s0 - mx), p1 = __expf(s1 - mx), p2 = lane == 0 ? __expf(s2 - mx) : 0.f;
        float sum = p0 + p1 + p2;
#pragma unroll
        for (int o = 1; o < 64; o <<= 1) sum += __shfl_xor(sum, o);
        const float inv = 1.f / (sum + __expf(sink - mx));
        sc[w * 132 + lane] = p0 * inv; sc[w * 132 + 64 + lane] = p1 * inv; if (lane == 0) sc[w * 132 + 128] = p2 * inv; }
    __syncthreads();
    if (tid < 256) { const int g = tid >> 6, d = tid & 63; float o = 0.f;
#pragma unroll 4
        for (int s = 0; s < 129; ++s) o += sc[g * 132 + s] * Vs[s * 65 + d];
        OA[(size_t)(MP + n) * DATT + (kvh * 4 + g) * 64 + d] = (bf16_t)(cvtpk(o, 0.f) & 0xffffu); }
    __syncthreads();
}
__device__ __forceinline__ void unpack8(const u32x4 v, float (&f)[8]) { f[0] = bf_lo(v.x); f[1] = bf_hi(v.x); f[2] = bf_lo(v.y); f[3] = bf_hi(v.y); f[4] = bf_lo(v.z); f[5] = bf_hi(v.z); f[6] = bf_lo(v.w); f[7] = bf_hi(v.w); }
__device__ __forceinline__ void conv_phase(const bf16_t* P, bf16_t* Z, const float* cw, const float* stc, float* out, int gtid, int NT) {
    for (int item = gtid; item < M * 64; item += NT) { const int r = item >> 6, c = (item & 63) * 8;
        const bf16_t* pr = P + (size_t)r * NPROJ;
        float cb[8], u0[8], u1[8], u2[8], t0[8], t1[8];
        unpack8(*(const u32x4*)(pr + C_CB + c), cb); unpack8(*(const u32x4*)(pr + C_CC + c), t0); unpack8(*(const u32x4*)(pr + C_CH + c), t1);
#pragma unroll
        for (int e = 0; e < 8; ++e) u0[e] = t0[e] * t1[e];
        if (r < MP) { const int t = r & (SEQ - 1);
            if (t >= 1) { unpack8(*(const u32x4*)(pr - NPROJ + C_CC + c), t0); unpack8(*(const u32x4*)(pr - NPROJ + C_CH + c), t1);
#pragma unroll
                for (int e = 0; e < 8; ++e) u1[e] = t0[e] * t1[e]; }
            else {
#pragma unroll
                for (int e = 0; e < 8; ++e) u1[e] = 0.f; }
            if (t >= 2) { unpack8(*(const u32x4*)(pr - 2 * NPROJ + C_CC + c), t0); unpack8(*(const u32x4*)(pr - 2 * NPROJ + C_CH + c), t1);
#pragma unroll
                for (int e = 0; e < 8; ++e) u2[e] = t0[e] * t1[e]; }
            else {
#pragma unroll
                for (int e = 0; e < 8; ++e) u2[e] = 0.f; }
            if (t >= SEQ - 2) { float* o = out + O_CP + (size_t)((r >> 13) * 2 + (t - (SEQ - 2))) * DC + c;
                *(f32x4*)o = (f32x4){u0[0], u0[1], u0[2], u0[3]}; *(f32x4*)(o + 4) = (f32x4){u0[4], u0[5], u0[6], u0[7]}; }
        } else { const int ns = r - MP; const float* s0 = stc + (size_t)(ns * 2) * DC + c; const float* s1 = s0 + DC;
            const f32x4 a0 = *(const f32x4*)s0, a1 = *(const f32x4*)(s0 + 4), b0 = *(const f32x4*)s1, b1 = *(const f32x4*)(s1 + 4);
            u2[0] = a0.x; u2[1] = a0.y; u2[2] = a0.z; u2[3] = a0.w; u2[4] = a1.x; u2[5] = a1.y; u2[6] = a1.z; u2[7] = a1.w;
            u1[0] = b0.x; u1[1] = b0.y; u1[2] = b0.z; u1[3] = b0.w; u1[4] = b1.x; u1[5] = b1.y; u1[6] = b1.z; u1[7] = b1.w;
            float* o = out + O_CS + (size_t)(ns * 2) * DC + c;
            *(f32x4*)o = b0; *(f32x4*)(o + 4) = b1; *(f32x4*)(o + DC) = (f32x4){u0[0], u0[1], u0[2], u0[3]}; *(f32x4*)(o + DC + 4) = (f32x4){u0[4], u0[5], u0[6], u0[7]}; }
        float z[8];
#pragma unroll
        for (int e = 0; e < 8; ++e) z[e] = cb[e] * (cw[c + e] * u2[e] + cw[DC + c + e] * u1[e] + cw[2 * DC + c + e] * u0[e]);
        u32x4 w; w.x = cvtpk(z[0], z[1]); w.y = cvtpk(z[2], z[3]); w.z = cvtpk(z[4], z[5]); w.w = cvtpk(z[6], z[7]);
        *(u32x4*)(Z + (size_t)r * DC + c) = w; }
    for (int item = gtid; item < 2 * 128 * 32; item += NT) { const int b = item >> 12, i = (item >> 5) & 127, c8 = (item & 31) * 8;
        float f[8]; unpack8(*(const u32x4*)(P + (size_t)(b * SEQ + SEQ - 128 + i) * NPROJ + C_K + c8), f);
        float* o = (c8 < 128 ? out + O_KP + (size_t)(b * 128 + i) * 128 + c8 : out + O_VP + (size_t)(b * 128 + i) * 128 + (c8 - 128));
        *(f32x4*)o = (f32x4){f[0], f[1], f[2], f[3]}; *(f32x4*)(o + 4) = (f32x4){f[4], f[5], f[6], f[7]}; }
}


template <int NSEG, class F> __device__ __forceinline__ void side_gemm(LAS unsigned char* lds, const bf16_t* A0, const bf16_t* B0, const bf16_t* A1, const bf16_t* B1, int K, int su, int tid, const F& f) {
    const int lane = tid & 63, w = tid >> 6, l15 = lane & 15, q = lane >> 4, rb = su >> 6, cb = su & 63, kw = K >> 3, nks = kw >> 5;
    f32x4 acc[NSEG][2];
#pragma unroll
    for (int sg = 0; sg < NSEG; ++sg) { acc[sg][0] = (f32x4){0.f, 0.f, 0.f, 0.f}; acc[sg][1] = (f32x4){0.f, 0.f, 0.f, 0.f};
        const bf16_t* Ap = (sg == 0 ? A0 : A1) + (size_t)(MP + 32 * rb + l15) * K + w * kw + 8 * q;
        const bf16_t* Bp = (sg == 0 ? B0 : B1) + (size_t)(16 * cb + l15) * K + w * kw + 8 * q;
        for (int ks = 0; ks < nks; ++ks) { const s16x8 a0 = *(const s16x8*)(Ap + 32 * ks), a1 = *(const s16x8*)(Ap + (size_t)16 * K + 32 * ks), b = *(const s16x8*)(Bp + 32 * ks);
            acc[sg][0] = __builtin_amdgcn_mfma_f32_16x16x32_bf16(b, a0, acc[sg][0], 0, 0, 0); acc[sg][1] = __builtin_amdgcn_mfma_f32_16x16x32_bf16(b, a1, acc[sg][1], 0, 0, 0); } }
    LAS f32x4* red = (LAS f32x4*)lds;
#pragma unroll
    for (int sg = 0; sg < NSEG; ++sg) { red[((sg * 2 + 0) * 8 + w) * 64 + lane] = acc[sg][0]; red[((sg * 2 + 1) * 8 + w) * 64 + lane] = acc[sg][1]; }
    __syncthreads();
    { const int row = tid >> 4, col = tid & 15, ln = (col >> 2) * 16 + (row & 15), reg = col & 3, rblk = row >> 4; float s[2] = {0.f, 0.f};
#pragma unroll
        for (int sg = 0; sg < NSEG; ++sg)
#pragma unroll
            for (int ww = 0; ww < 8; ++ww) s[sg] += ((const LAS float*)(red + ((sg * 2 + rblk) * 8 + ww) * 64 + ln))[reg];
        f(s[0], s[1], MP + 32 * rb + row, 16 * cb + col); }
    __syncthreads();
}
template <bool OUT_BF16> __device__ __forceinline__ void ln_phase(const float* H, const float* gam, const float* bet, bf16_t* Xo, float* out, int gw, int NGW, int lane) {
    f32x4 g4[4], b4[4];
#pragma unroll
    for (int j = 0; j < 4; ++j) { g4[j] = ((const f32x4*)gam)[lane + 64 * j]; b4[j] = ((const f32x4*)bet)[lane + 64 * j]; }
    for (int m = gw; m < M; m += NGW) {
        const f32x4* xr = (const f32x4*)(H + (size_t)m * D) + lane;
        f32x4 v[4]; float s = 0.f;
#pragma unroll
        for (int j = 0; j < 4; ++j) { v[j] = xr[64 * j]; s += (v[j].x + v[j].y) + (v[j].z + v[j].w); }
        const float mean = wave_sum(s) * (1.f / D); float s2 = 0.f;
#pragma unroll
        for (int j = 0; j < 4; ++j) { v[j] = v[j] - mean; s2 += (v[j].x * v[j].x + v[j].y * v[j].y) + (v[j].z * v[j].z + v[j].w * v[j].w); }
        const float rstd = 1.f / sqrtf(wave_sum(s2) * (1.f / D) + LN_EPS);
        if (OUT_BF16) { unsigned long long* o8 = (unsigned long long*)(Xo + (size_t)m * D) + lane;
#pragma unroll
            for (int j = 0; j < 4; ++j) { const f32x4 y = v[j] * rstd * g4[j] + b4[j]; o8[64 * j] = (unsigned long long)cvtpk(y.x, y.y) | ((unsigned long long)cvtpk(y.z, y.w) << 32); }
        } else { f32x4* o = (f32x4*)(m < MP ? out + O_YP + (size_t)m * D : out + O_YS + (size_t)(m - MP) * D) + lane;
#pragma unroll
            for (int j = 0; j < 4; ++j) o[64 * j] = v[j] * rstd * g4[j] + b4[j]; }
    }
}
__device__ __forceinline__ void halo_phase(const float* HB, const float* cw, bf16_t* ACT, int gtid, int NT) {
    constexpr int C4 = FF / 4;
    for (int item = gtid; item < (MP / 64) * 2 * C4; item += NT) { const int c4 = (item % C4) * 4, rr = item / C4, G = rr >> 1, j = rr & 1;
        const float* hb = HB + (size_t)G * 6 * FF + c4; const bool first = (G & 127) == 0;
        const f32x4 z = {0.f, 0.f, 0.f, 0.f};
        const f32x4 g0 = *(const f32x4*)hb, pl1 = first ? z : *(const f32x4*)(hb - 6 * FF + 3 * FF);
        f32x4 cur, gm1, gm2, upv;
        if (j == 0) { cur = g0; gm1 = pl1; gm2 = first ? z : *(const f32x4*)(hb - 6 * FF + 2 * FF); upv = *(const f32x4*)(hb + 4 * FF); }
        else { cur = *(const f32x4*)(hb + FF); gm1 = g0; gm2 = pl1; upv = *(const f32x4*)(hb + 5 * FF); }
        const f32x4 w0 = *(const f32x4*)(cw + c4), w1 = *(const f32x4*)(cw + FF + c4), w2 = *(const f32x4*)(cw + 2 * FF + c4);
        const f32x4 a = gelu4(w0 * gm2 + w1 * gm1 + w2 * cur) * upv;
        u32x2 w; w.x = cvtpk(a[0], a[1]); w.y = cvtpk(a[2], a[3]);
        *(u32x2*)(ACT + (size_t)(64 * G + j) * FF + c4) = w; }
}

#ifndef MK_N_LAUNCHES
#define MK_N_LAUNCHES 1
#endif
constexpr int NPH = 10;
struct Args { const float* in[20]; float* out; unsigned char* ws; int ph_lo, ph_hi, never, pad; };
__global__ void __launch_bounds__(NWAVES * 64, 2) fwd_kernel(Args args) {
    extern __shared__ __attribute__((aligned(16))) unsigned char lds_raw[];
    LAS unsigned char* lds = (LAS unsigned char*)lds_raw;
    volatile LAS unsigned* MISC = (volatile LAS unsigned*)(lds + MISC_OFF);
    const int tid = threadIdx.x, lane = tid & 63, wave = __builtin_amdgcn_readfirstlane(tid >> 6);
    const int G = gridDim.x, bx = blockIdx.x;
    const int gw = bx * NWAVES + wave, NGW = G * NWAVES, gtid = bx * (NWAVES * 64) + tid, NT = G * NWAVES * 64;
    unsigned char* ws = args.ws; float* out = args.out;
    In I; I.xp = args.in[0]; I.xs = args.in[1]; I.ck = args.in[2]; I.cv = args.in[3]; I.stc = args.in[4]; I.stf = args.in[5]; I.w_in = args.in[6]; I.conv_w = args.in[7]; I.sinks = args.in[8];
    I.w_ao = args.in[9]; I.w_co = args.in[10]; I.w_mix = args.in[11]; I.ln1g = args.in[12]; I.ln1b = args.in[13]; I.w_gate = args.in[14]; I.w_up = args.in[15]; I.fcw = args.in[16]; I.w_down = args.in[17];
    I.ln2g = args.in[18]; I.ln2b = args.in[19];
    if (args.never) cg::this_grid().sync();
    for (int u = tid; u < (LDS_BYTES - MISC_OFF) / 4; u += NWAVES * 64) ((LAS unsigned*)(lds + MISC_OFF))[u] = 0u;
    __syncthreads();
    const int lo = args.ph_lo, hi = args.ph_hi;
    const bool multi = (hi - lo) > 1;
    XcdBarrier bar; bar.bar = (unsigned*)(ws + WS_CTL) + CW_BAR; bar.x = 0; bar.st = nullptr;
    if (multi) bar = xcd_barrier_post((unsigned*)(ws + WS_CTL) + CW_BAR, MISC + 8);
#ifndef PH_MASK
#define PH_MASK 0x3ff
#endif
#define IN(k) (((PH_MASK >> (k)) & 1) && lo <= (k) && (k) < hi)
#define SEAM(k) do { if (IN(k) && IN((k) + 1)) xcd_barrier(bar); } while (0)
    bf16_t* const XB = (bf16_t*)(ws + WS_A); bf16_t* const MG = (bf16_t*)(ws + WS_A); bf16_t* const OATT = (bf16_t*)(ws + WS_OATT); bf16_t* const Z = (bf16_t*)(ws + WS_Z);
    bf16_t* const P = (bf16_t*)(ws + WS_P); bf16_t* const X1 = (bf16_t*)(ws + WS_X1); float* const H1 = (float*)(ws + WS_H1); bf16_t* const ACT = (bf16_t*)(ws + WS_ACT);
    float* const H2 = (float*)(ws + WS_H2); float* const HB = (float*)(ws + WS_HB);

#ifndef REP_MASK
#define REP_MASK 0
#endif
#define REPS(k) (((REP_MASK >> (k)) & 1) ? 2 : 1)
    if (IN(0)) for (int rep = 0; rep < REPS(0); ++rep) { if (rep) xcd_barrier(bar); p0_prologue(I, ws, lds, gw, NGW, wave, lane); }
    SEAM(0);
    if (IN(1)) {
        pg8::Gemm g{XB, (const bf16_t*)(ws + WS_WIN), MPAD, NPROJ, D}; pg8::StaticOrder S; S.init(MPAD, NPROJ, G, bx);
        pg8::EpiBf16<0> E{P, NPROJ, nullptr, 0, 0, 1.f};
        pg8::gemm_phase<pg8::EpiBf16<0>, pg8::StaticOrder, true, true>(lds, g, S, E);
    }
    SEAM(1);
    if (IN(2)) for (int rep = 0; rep < REPS(2); ++rep) { if (rep) xcd_barrier(bar);
        for (int un = bx; un < 512; un += G) {
#ifndef NO_AP
            if (un < 256) attn_prompt_unit(lds, P, OATT, I.sinks, un >> 7, (un >> 1) & 63, un & 1, tid);
#endif
#ifndef NO_AS
            if (un >= 256) attn_sample_unit(lds, P, OATT, I.ck, I.cv, I.sinks, out, (un - 256) >> 1, un & 1, tid);
#endif
        }
#ifndef NO_CV
        conv_phase(P, Z, I.conv_w, I.stc, out, gtid, NT);
#endif
    }
    SEAM(2);
    if (IN(3)) {
        pg8::StaticOrder S; S.init(MP, D, G, bx);
        { pg8::Gemm g{OATT, (const bf16_t*)(ws + WS_WAO), MP, D, DATT}; EpiGate<0> E{P, MG}; pg8::gemm_phase<EpiGate<0>, pg8::StaticOrder, true, true>(lds, g, S, E); }
        { pg8::Gemm g{Z, (const bf16_t*)(ws + WS_WCO), MP, D, DC}; EpiGate<1> E{P, MG}; pg8::gemm_phase<EpiGate<1>, pg8::StaticOrder, true, true>(lds, g, S, E); }
        for (int su = bx; su < 256; su += G)
            side_gemm<2>(lds, OATT, (const bf16_t*)(ws + WS_WAO), Z, (const bf16_t*)(ws + WS_WCO), DATT, su, tid, [&](float s0, float s1, int r, int c) {
                const bf16_t* pr = P + (size_t)r * NPROJ + c; MG[(size_t)r * D + c] = (bf16_t)(cvtpk(sigm(bf1(pr[C_GA])) * s0 + sigm(bf1(pr[C_GB])) * s1, 0.f) & 0xffffu); });
    }
    SEAM(3);
    if (IN(4)) {
        pg8::Gemm g{MG, (const bf16_t*)(ws + WS_WMIX), MP, D, D}; pg8::StaticOrder S; S.init(MP, D, G, bx);
        EpiResX E{I.xp, I.xs, H1}; pg8::gemm_phase<EpiResX, pg8::StaticOrder, true, true>(lds, g, S, E);
        const float* xs = I.xs;
        for (int su = bx; su < 256; su += G)
            side_gemm<1>(lds, MG, (const bf16_t*)(ws + WS_WMIX), nullptr, nullptr, D, su, tid, [&](float s0, float, int r, int c) {
                H1[(size_t)r * D + c] = DN_ALPHA * xs[(size_t)(r - MP) * D + c] + s0; });
    }
    SEAM(4);
    if (IN(5)) ln_phase<true>(H1, I.ln1g, I.ln1b, X1, nullptr, gw, NGW, lane);
    SEAM(5);
    if (IN(6)) {
        pg8::Gemm g{X1, (const bf16_t*)(ws + WS_WGU), MPAD, 2 * FF, D}; pg8::StaticOrder S; S.init(MPAD, 2 * FF, G, bx);
        EpiGU E{ACT, HB, I.fcw, I.stf, out}; pg8::gemm_phase<EpiGU, pg8::StaticOrder, true, true>(lds, g, S, E);
    }
    SEAM(6);
    if (IN(7)) halo_phase(HB, I.fcw, ACT, gtid, NT);
    SEAM(7);
    if (IN(8)) {
        pg8::Gemm g{ACT, (const bf16_t*)(ws + WS_WD), MP, D, FF}; pg8::StaticOrder S; S.init(MP, D, G, bx);
        EpiResB E{X1, H2}; pg8::gemm_phase<EpiResB, pg8::StaticOrder, true, true>(lds, g, S, E);
        for (int su = bx; su < 256; su += G)
            side_gemm<1>(lds, ACT, (const bf16_t*)(ws + WS_WD), nullptr, nullptr, FF, su, tid, [&](float s0, float, int r, int c) {
                H2[(size_t)r * D + c] = DN_ALPHA * bf1(X1[(size_t)r * D + c]) + s0; });
    }
    SEAM(8);
    if (IN(9)) ln_phase<false>(H2, I.ln2g, I.ln2b, nullptr, out, gw, NGW, lane);
#undef IN
#undef SEAM
}

extern "C" void kernel_launch(void* const* d_in, const int* in_sizes, int n_in, void* d_out, int out_size, void* d_ws, size_t ws_size, hipStream_t stream) {
    static int grid = 0;
    if (grid == 0) {
        if (n_in != 20 || (size_t)out_size != O_END || ws_size < WS_END) { fprintf(stderr, "kernel_launch: unexpected shapes: n_in %d out %d ws %zu (need %zu)\n", n_in, out_size, ws_size, (size_t)WS_END); grid = -1; return; }
        int dev = 0, cus = 0, per_cu = 0;
        if (hipGetDevice(&dev) != hipSuccess || hipDeviceGetAttribute(&cus, hipDeviceAttributeMultiprocessorCount, dev) != hipSuccess) { grid = -1; return; }
        if (hipFuncSetAttribute((const void*)fwd_kernel, hipFuncAttributeMaxDynamicSharedMemorySize, LDS_BYTES) != hipSuccess) { fprintf(stderr, "kernel_launch: hipFuncSetAttribute failed\n"); grid = -1; return; }
        if (hipOccupancyMaxActiveBlocksPerMultiprocessor(&per_cu, (const void*)fwd_kernel, NWAVES * 64, LDS_BYTES) != hipSuccess || per_cu < 1) { fprintf(stderr, "kernel_launch: occupancy query says %d\n", per_cu); per_cu = 1; }
        (void)hipGetLastError();
        grid = cus;
    }
    if (grid < 0) return;
    (void)hipMemsetAsync((char*)d_ws + WS_CTL, 0, CTL_ZERO_BYTES, stream);
    Args a{};
    for (int i = 0; i < 20; ++i) a.in[i] = (const float*)d_in[i];
    a.out = (float*)d_out; a.ws = (unsigned char*)d_ws; a.never = 0; a.pad = 0;
#if MK_N_LAUNCHES == 1
    a.ph_lo = 0; a.ph_hi = NPH;
    void* kargs[] = {&a};
    hipError_t e = hipLaunchCooperativeKernel((const void*)fwd_kernel, dim3(grid), dim3(NWAVES * 64), kargs, LDS_BYTES, stream);
    if (e != hipSuccess) fprintf(stderr, "kernel_launch: cooperative launch failed: %s (grid %d)\n", hipGetErrorString(e), grid);
#else
    for (int k = 0; k < NPH; ++k) { a.ph_lo = k; a.ph_hi = k + 1; hipLaunchKernelGGL(fwd_kernel, dim3(grid), dim3(NWAVES * 64), LDS_BYTES, stream, a); }
#endif
}
```
